# Optimizing an MI355X kernel written in HIP

```python
import math
import jax, jax.numpy as jnp
from jax import lax
import numpy as np

D_MODEL = 1024
BATCH = 16
SEQ = 256
DEPTH = 4
DEC_BATCH = 2
DEC_SEQ = 2048
PAST_LEN = 256

GRID_W = 64
BR_W = 512
HY_W = BR_W
HY_EMB = 33
HY_BANDS = (HY_EMB - 1) // 2
HY_FFN = 64
HY_MAX_DECAY = math.log(1e-2) / 0.3
HY_MIN_DECAY = math.log(1e-2) / 1.5
RW_N = 64
RW_H = BR_W // RW_N
RW_W = RW_H * RW_N
W_LORA = 64
A_LORA = 64
RW_DECAY_SCALE = math.exp(-0.5)
RW_GN_EPS = 64e-5
DA_DH = 64
DA_H = BR_W // (2 * DA_DH)
DA_QW = DA_H * 2 * DA_DH
DA_VW = DA_H * 2 * DA_DH
ROPE_AXIS = DA_DH // 2
ROPE_BASE = 10000.0
Q_BLOCK = 128
NORM_EPS = 1e-6
N_BRANCH = 3
RW_SHIFT_W = 3 * RW_W + 2 * W_LORA + 2 * A_LORA
IN_SIZES = (3 * HY_W, HY_W, RW_SHIFT_W, RW_W, DA_QW, DA_QW, DA_VW, DA_VW, N_BRANCH * D_MODEL)
N_IN = sum(IN_SIZES)
IN_SPLITS = tuple(int(s) for s in np.cumsum(IN_SIZES)[:-1])

kernel_name = "hyena_rwkv7_diffattn_prefix_dit"

F32 = jnp.float32


def _rmsnorm(x, g, eps=NORM_EPS):
    xf = x.astype(F32)
    y = xf * lax.rsqrt(jnp.mean(xf * xf, axis=-1, keepdims=True) + eps)
    return (y * g.astype(F32)).astype(x.dtype)


def _centred_conv3(u, w, b):
    up = jnp.pad(u, ((0, 0), (1, 1), (0, 0)))
    return up[:, :-2] * w[0] + up[:, 1:-1] * w[1] + up[:, 2:] * w[2] + b


def _hyena_filters(L, f1, fb1, freq, f2, fb2, f3):
    t = jnp.linspace(0.0, 1.0, L, dtype=F32)[:, None]
    w = 2.0 * math.pi * jnp.arange(L, dtype=F32)[:, None] / L
    bands = jnp.linspace(1e-4, HY_BANDS - 1, HY_BANDS, dtype=F32)[None, :]
    z = jnp.concatenate([t, jnp.cos(bands * w), -jnp.sin(bands * w)], axis=-1)
    freq = freq.astype(F32)
    hid = jnp.sin(freq * (z @ f1.astype(F32) + fb1.astype(F32)))
    hid = jnp.sin(freq * (hid @ f2.astype(F32) + fb2.astype(F32)))
    h = hid @ f3.astype(F32)
    deltas = jnp.linspace(HY_MIN_DECAY, HY_MAX_DECAY, HY_W, dtype=F32)
    window = jnp.exp(-t * jnp.abs(deltas)[None, :])
    return h[:, :HY_W] * window, h[:, HY_W:] * window


def _long_conv_bidir(u, h_f, h_b, bias_d):
    L = u.shape[1]
    C = u.shape[2]
    h_full = jnp.concatenate([h_f, jnp.zeros((1, C), F32), h_b[1:][::-1]], axis=0)
    uf = u.astype(F32)
    U = jnp.fft.rfft(uf, n=2 * L, axis=1)
    H = jnp.fft.rfft(h_full, n=2 * L, axis=0)
    y = jnp.fft.irfft(U * H[None], n=2 * L, axis=1)[:, :L]
    return y + uf * bias_d.astype(F32)


def _hyena_branch(z, gate, p):
    u = _centred_conv3(z, p["hy_conv_w"], p["hy_conv_b"])
    v, x1, x2 = jnp.split(u, 3, axis=-1)
    h_f, h_b = _hyena_filters(u.shape[1], p["hy_f1"], p["hy_fb1"], p["hy_freq"],
                              p["hy_f2"], p["hy_fb2"], p["hy_f3"])
    y = x1.astype(F32) * _long_conv_bidir(x2 * v, h_f, h_b, p["hy_bias"])
    return (y * jax.nn.silu(gate.astype(F32))).astype(z.dtype)


def _rwkv_scan(r, w, kk, a, k, v, s0, reverse):
    def step(S, inp):
        r_t, w_t, kk_t, a_t, k_t, v_t = inp
        sa = jnp.einsum('bhvk,bhk->bhv', S, -kk_t)
        S = (S * w_t[:, :, None, :] + sa[..., None] * (kk_t * a_t)[:, :, None, :]
             + v_t[..., None] * k_t[:, :, None, :])
        return S, jnp.einsum('bhvk,bhk->bhv', S, r_t)
    xs = tuple(jnp.moveaxis(t, 1, 0) for t in (r, w, kk, a, k, v))
    S, ys = lax.scan(step, s0.astype(F32), xs, reverse=reverse)
    return jnp.moveaxis(ys, 0, 1), S


def _rwkv_branch(zr, gate, p, s0_f, s0_b):
    B, L, _ = zr.shape
    zr = zr.astype(F32)
    zp = jnp.pad(zr, ((0, 0), (1, 1), (0, 0)))
    nbr = 0.5 * (zp[:, :-2] + zp[:, 2:])
    zr = zr + p["rw_mu"].astype(F32) * (nbr - zr)
    r, k, v, wl, al = jnp.split(zr, [RW_W, 2 * RW_W, 3 * RW_W, 3 * RW_W + 2 * W_LORA], axis=-1)
    wls = jnp.split(wl, 2, axis=-1)
    als = jnp.split(al, 2, axis=-1)
    heads = lambda t: t.reshape(B, L, RW_H, RW_N)
    kk = heads(k * p["rw_kk"].astype(F32))
    kk = kk * lax.rsqrt(jnp.sum(kk * kk, axis=-1, keepdims=True) + 1e-12)
    ys, states, kds = [], [], []
    for d, (s0, rev) in enumerate(((s0_f, False), (s0_b, True))):
        w = jnp.exp(-RW_DECAY_SCALE * jax.nn.sigmoid(
            p["rw_w0"][d].astype(F32) + jnp.tanh(wls[d]) @ p["rw_w2"][d].astype(F32)))
        a = jax.nn.sigmoid(p["rw_a0"][d].astype(F32) + als[d] @ p["rw_a2"][d].astype(F32))
        kd = k * (1.0 + (a - 1.0) * p["rw_ka"].astype(F32))
        y, s = _rwkv_scan(heads(r), heads(w), kk, heads(a), heads(kd), heads(v), s0, rev)
        ys.append(y)
        states.append(s)
        kds.append(kd)
    y = ys[0] + ys[1]
    mu = jnp.mean(y, axis=-1, keepdims=True)
    var = jnp.mean(jnp.square(y - mu), axis=-1, keepdims=True)
    y = ((y - mu) * lax.rsqrt(var + RW_GN_EPS)).reshape(B, L, RW_W)
    y = y * p["rw_ln_w"].astype(F32) + p["rw_ln_b"].astype(F32)
    k_mix = heads(0.5 * (kds[0] + kds[1]))
    bonus = jnp.sum(heads(r) * k_mix * p["rw_rk"].astype(F32), axis=-1, keepdims=True) * heads(v)
    y = (y + bonus.reshape(B, L, RW_W)) * jax.nn.silu(gate.astype(F32))
    return y.astype(gate.dtype), states[0], states[1]


def _rope_axis(x, pos):
    half = ROPE_AXIS // 2
    freqs = ROPE_BASE ** (-jnp.arange(half, dtype=F32) / half)
    ang = pos.astype(F32)[:, None] * freqs[None, :]
    cos = jnp.cos(ang)[None, :, None, None, :]
    sin = jnp.sin(ang)[None, :, None, None, :]
    x1, x2 = x[..., :half], x[..., half:]
    return jnp.concatenate([x1 * cos - x2 * sin, x1 * sin + x2 * cos], axis=-1)


def _rope2d(x):
    L = x.shape[1]
    rows = L // GRID_W
    row = jnp.repeat(jnp.arange(rows), GRID_W)
    col = jnp.tile(jnp.arange(GRID_W), rows)
    xf = x.astype(F32)
    out = jnp.concatenate([_rope_axis(xf[..., :ROPE_AXIS], row),
                           _rope_axis(xf[..., ROPE_AXIS:], col)], axis=-1)
    return out.astype(x.dtype)


def _diff_attention(q, k, v, lam):
    B, Lq, H, _, Dh = q.shape
    nb = Lq // Q_BLOCK
    qb = jnp.moveaxis(q.reshape(B, nb, Q_BLOCK, H, 2, Dh), 1, 0)
    kf = k.astype(F32)
    vf = v.astype(F32)
    scale = Dh ** -0.5

    def block(qi):
        s = jnp.einsum('bqhmd,bkhmd->bhmqk', qi.astype(F32), kf) * scale
        pr = jax.nn.softmax(s, axis=-1)
        pd = pr[:, :, 0] - lam * pr[:, :, 1]
        return jnp.einsum('bhqk,bkhe->bqhe', pd, vf)
    o = lax.map(block, qb)
    return jnp.moveaxis(o, 0, 1).reshape(B, Lq, H, 2 * Dh)


def _diff_branch(q, k, v, gate, p, lam_init, ctx_kv):
    B, L, _ = q.shape
    q = _rmsnorm(q.reshape(B, L, DA_H, 2, DA_DH), p["da_gq"])
    k = _rmsnorm(k.reshape(B, L, DA_H, 2, DA_DH), p["da_gk"])
    v = v.reshape(B, L, DA_H, 2 * DA_DH)
    if ctx_kv is None:
        keys, vals = k, v
    else:
        q = _rope2d(q)
        keys = jnp.concatenate([ctx_kv[0].astype(k.dtype), _rope2d(k)], axis=1)
        vals = jnp.concatenate([ctx_kv[1].astype(v.dtype), v], axis=1)
    lam = (jnp.exp(jnp.sum(p["da_lq1"].astype(F32) * p["da_lk1"].astype(F32)))
           - jnp.exp(jnp.sum(p["da_lq2"].astype(F32) * p["da_lk2"].astype(F32))) + lam_init)
    o = _diff_attention(q, keys, vals, lam)
    o = _rmsnorm(o, p["da_gsub"], 1e-5) * (1.0 - lam_init)
    y = o.reshape(B, L, DA_VW) * jax.nn.silu(gate.astype(F32))
    return y.astype(gate.dtype), k, v


def _layer(x, cvec, p, lam_init, ctx):
    mod = jax.nn.silu(cvec) @ p["w_ada"] + p["b_ada"]
    shift, scale, gate = jnp.split(mod, 3, axis=-1)
    h = _rmsnorm(x, p["norm_g"]) * (1.0 + scale[:, None, :]) + shift[:, None, :]
    z = h @ p["w_in"]
    hy_z, hy_g, rw_z, rw_g, da_q, da_k, da_v, da_g, mg = jnp.split(z, IN_SPLITS, axis=-1)
    if ctx is None:
        s0 = jnp.zeros((x.shape[0], RW_H, RW_N, RW_N), F32)
        s0_f, s0_b, ctx_kv = s0, s0, None
    else:
        ctx_k, ctx_v, s0_f, s0_b = ctx
        ctx_kv = (ctx_k, ctx_v)
    y_a = _hyena_branch(hy_z, hy_g, p)
    y_b, s_f, s_b = _rwkv_branch(rw_z, rw_g, p, s0_f, s0_b)
    y_c, k_c, v_c = _diff_branch(da_q, da_k, da_v, da_g, p, lam_init, ctx_kv)
    g_a, g_b, g_c = jnp.split(jax.nn.sigmoid(mg.astype(F32)), 3, axis=-1)
    merged = (g_a * (y_a @ p["w_br"][0]) + g_b * (y_b @ p["w_br"][1])
              + g_c * (y_c @ p["w_br"][2]))
    out = merged.astype(x.dtype) @ p["w_out"]
    x_new = x + (gate[:, None, :] * out).astype(x.dtype)
    if ctx is None:
        return x_new, (k_c, v_c, jnp.stack([s_f, s_b], axis=1))
    return x_new, None


def setup_inputs(seed: int = 0) -> dict:
    key = jax.random.key(seed)
    ks = iter(jax.random.split(key, 48))
    nrm = lambda shape, s=1.0: jax.random.normal(next(ks), shape, F32) * s
    D = D_MODEL
    return {
        "x_prompt": nrm((BATCH, SEQ, D)),
        "x_sample": nrm((DEC_BATCH, DEC_SEQ, D)),
        "cache_k": nrm((DEC_BATCH, DEPTH, PAST_LEN, DA_H, 2, DA_DH)),
        "cache_v": nrm((DEC_BATCH, DEPTH, PAST_LEN, DA_H, 2 * DA_DH)),
        "state_rwkv": nrm((DEC_BATCH, DEPTH, 2, RW_H, RW_N, RW_N), 0.5),
        "c": nrm((DEC_BATCH, D)),
        "c_ctx": nrm((D,)),
        "norm_g": 1.0 + nrm((DEPTH, D), 0.05),
        "w_ada": nrm((DEPTH, D, 3 * D), 0.02),
        "b_ada": nrm((DEPTH, 3 * D), 0.01),
        "w_in": nrm((DEPTH, D, N_IN), D ** -0.5),
        "hy_conv_w": nrm((DEPTH, 3, 3 * HY_W), 3 ** -0.5),
        "hy_conv_b": nrm((DEPTH, 3 * HY_W), 0.01),
        "hy_f1": nrm((DEPTH, HY_EMB, HY_FFN), HY_EMB ** -0.5),
        "hy_fb1": nrm((DEPTH, HY_FFN), 0.1),
        "hy_freq": 1.0 + nrm((DEPTH, HY_FFN), 0.05),
        "hy_f2": nrm((DEPTH, HY_FFN, HY_FFN), HY_FFN ** -0.5),
        "hy_fb2": nrm((DEPTH, HY_FFN), 0.1),
        "hy_f3": nrm((DEPTH, HY_FFN, 2 * HY_W), 0.05 * HY_FFN ** -0.5),
        "hy_bias": nrm((DEPTH, HY_W), 0.1),
        "rw_mu": jax.random.uniform(next(ks), (DEPTH, RW_SHIFT_W), F32),
        "rw_w0": nrm((DEPTH, 2, RW_W), 0.5),
        "rw_w2": nrm((DEPTH, 2, W_LORA, RW_W), W_LORA ** -0.5),
        "rw_a0": nrm((DEPTH, 2, RW_W), 0.5),
        "rw_a2": nrm((DEPTH, 2, A_LORA, RW_W), 0.5 * A_LORA ** -0.5),
        "rw_kk": 0.85 + nrm((DEPTH, RW_W), 0.05),
        "rw_ka": 1.0 + nrm((DEPTH, RW_W), 0.05),
        "rw_rk": nrm((DEPTH, RW_H, RW_N), 0.1),
        "rw_ln_w": 1.0 + nrm((DEPTH, RW_W), 0.05),
        "rw_ln_b": nrm((DEPTH, RW_W), 0.01),
        "da_gq": 1.0 + nrm((DEPTH, DA_DH), 0.05),
        "da_gk": 1.0 + nrm((DEPTH, DA_DH), 0.05),
        "da_lq1": nrm((DEPTH, DA_DH), 0.1),
        "da_lk1": nrm((DEPTH, DA_DH), 0.1),
        "da_lq2": nrm((DEPTH, DA_DH), 0.1),
        "da_lk2": nrm((DEPTH, DA_DH), 0.1),
        "da_gsub": 1.0 + nrm((DEPTH, 2 * DA_DH), 0.05),
        "w_br": nrm((DEPTH, N_BRANCH, BR_W, D), BR_W ** -0.5),
        "w_out": nrm((DEPTH, D, D), D ** -0.5),
    }


def reference(x_prompt, x_sample, cache_k, cache_v, state_rwkv, c, c_ctx,
              norm_g, w_ada, b_ada, w_in, hy_conv_w, hy_conv_b, hy_f1, hy_fb1, hy_freq,
              hy_f2, hy_fb2, hy_f3, hy_bias, rw_mu, rw_w0, rw_w2, rw_a0, rw_a2, rw_kk, rw_ka,
              rw_rk, rw_ln_w, rw_ln_b, da_gq, da_gk, da_lq1, da_lk1, da_lq2, da_lk2, da_gsub,
              w_br, w_out):
    def layer_params(l):
        return dict(norm_g=norm_g[l], w_ada=w_ada[l], b_ada=b_ada[l], w_in=w_in[l],
                    hy_conv_w=hy_conv_w[l], hy_conv_b=hy_conv_b[l], hy_f1=hy_f1[l], hy_fb1=hy_fb1[l],
                    hy_freq=hy_freq[l], hy_f2=hy_f2[l], hy_fb2=hy_fb2[l], hy_f3=hy_f3[l],
                    hy_bias=hy_bias[l], rw_mu=rw_mu[l], rw_w0=rw_w0[l], rw_w2=rw_w2[l],
                    rw_a0=rw_a0[l], rw_a2=rw_a2[l], rw_kk=rw_kk[l], rw_ka=rw_ka[l], rw_rk=rw_rk[l],
                    rw_ln_w=rw_ln_w[l], rw_ln_b=rw_ln_b[l], da_gq=da_gq[l], da_gk=da_gk[l],
                    da_lq1=da_lq1[l], da_lk1=da_lk1[l], da_lq2=da_lq2[l], da_lk2=da_lk2[l],
                    da_gsub=da_gsub[l], w_br=w_br[l], w_out=w_out[l])

    c_prompt = jnp.broadcast_to(c_ctx, (x_prompt.shape[0], D_MODEL))
    xp = x_prompt
    new_k, new_v, new_s = [], [], []
    for l in range(DEPTH):
        lam_init = 0.8 - 0.6 * math.exp(-0.3 * l)
        xp, (k_l, v_l, s_l) = _layer(xp, c_prompt, layer_params(l), lam_init, None)
        new_k.append(k_l)
        new_v.append(v_l)
        new_s.append(s_l)
    new_cache_k = jnp.stack(new_k, axis=1)
    new_cache_v = jnp.stack(new_v, axis=1)
    new_state_rwkv = jnp.stack(new_s, axis=1)

    xs = x_sample
    for l in range(DEPTH):
        lam_init = 0.8 - 0.6 * math.exp(-0.3 * l)
        ctx = (cache_k[:, l], cache_v[:, l], state_rwkv[:, l, 0], state_rwkv[:, l, 1])
        xs, _ = _layer(xs, c, layer_params(l), lam_init, ctx)
    return (xp, xs, new_cache_k, new_cache_v, new_state_rwkv)
```

```cpp
#include <hip/hip_runtime.h>
#include <hip/hip_bf16.h>
#include <hip/hip_cooperative_groups.h>
#include <cstdio>
namespace cg = cooperative_groups;

#define DEV __device__ __forceinline__
typedef unsigned short bf16_t;
using bf16x8 = __attribute__((ext_vector_type(8))) short;
using f32x4 = __attribute__((ext_vector_type(4))) float;
using v2f = __attribute__((ext_vector_type(2))) float;

constexpr int NT = 256;
constexpr int MTOK = 8192;
constexpr int NIN = 9472;
constexpr int C_HYZ = 0, C_HYG = 1536, C_RWZ = 2048, C_RWG = 3840, C_DAQ = 4352, C_DAK = 4864, C_DAV = 5376,
              C_DAG = 5888, C_MG = 6400;
constexpr int SMEM_BYTES = 43008;
constexpr int XCD_BAR_WORDS_C = 3456;

constexpr size_t O_YP = 0, O_YS = 4194304, O_CK = 8388608, O_CV = 16777216, O_ST = 25165824;

constexpr size_t SZ_TOK512F = (size_t)MTOK * 512 * 4;
constexpr size_t OFF_WTIN = 0;
constexpr size_t OFF_WTBR = OFF_WTIN + (size_t)4 * 9472 * 1024 * 2;
constexpr size_t OFF_WTOUT = OFF_WTBR + (size_t)4 * 3 * 1024 * 512 * 2;
constexpr size_t OFF_MOD = OFF_WTOUT + (size_t)4 * 1024 * 1024 * 2;
constexpr size_t OFF_G = OFF_MOD + (size_t)4 * 3 * 3072 * 4;
constexpr size_t GR_CTX_DW = (size_t)512 * 2 * 272;
constexpr size_t GR_SMP_DW = (size_t)512 * 2 * 2064;
constexpr size_t GR_LAYER_DW = GR_CTX_DW + GR_SMP_DW;
constexpr size_t OFF_ROPE = OFF_G + 4 * GR_LAYER_DW * 4;
constexpr size_t OFF_LAM = OFF_ROPE + 8192;
constexpr size_t OFF_H = OFF_LAM + 256;
constexpr size_t OFF_Z = OFF_H + (size_t)MTOK * 1024 * 2;
constexpr size_t OFF_UU = OFF_Z + (size_t)MTOK * NIN * 2;
constexpr size_t OFF_X1 = OFF_UU + SZ_TOK512F;
constexpr size_t OFF_R = OFF_X1 + SZ_TOK512F;
constexpr size_t OFF_KK = OFF_R + SZ_TOK512F;
constexpr size_t OFF_V = OFF_KK + SZ_TOK512F;
constexpr size_t OFF_W = OFF_V + SZ_TOK512F;
constexpr size_t OFF_BV = OFF_W + 2 * SZ_TOK512F;
constexpr size_t OFF_KD = OFF_BV + 2 * SZ_TOK512F;
constexpr size_t OFF_Y = OFF_KD + 2 * SZ_TOK512F;
constexpr size_t OFF_Q = OFF_Y + 2 * SZ_TOK512F;
constexpr size_t OFF_K = OFF_Q + (size_t)MTOK * 512 * 2;
constexpr size_t KROWS = 4096 + 2 * 2304;
constexpr size_t OFF_VT = OFF_K + KROWS * 512 * 2;
constexpr size_t OFF_YA = OFF_VT + KROWS * 512 * 2;
constexpr size_t OFF_YB = OFF_YA + (size_t)MTOK * 512 * 2;
constexpr size_t OFF_YC = OFF_YB + (size_t)MTOK * 512 * 2;
constexpr size_t OFF_CNT = OFF_YC + (size_t)MTOK * 512 * 2;
constexpr size_t OFF_BAR = OFF_CNT + 256;
constexpr size_t WS_NEED = OFF_BAR + XCD_BAR_WORDS_C * 4;

struct Params {
  const float* in[39];
  float* out;
  char* ws;
};

enum { I_XP = 0, I_XS, I_CK, I_CV, I_ST, I_C, I_CCTX, I_NORMG, I_WADA, I_BADA, I_WIN, I_HCW, I_HCB, I_HF1, I_HFB1,
       I_HFREQ, I_HF2, I_HFB2, I_HF3, I_HBIAS, I_RMU, I_RW0, I_RW2, I_RA0, I_RA2, I_RKK, I_RKA, I_RRK, I_RLNW,
       I_RLNB, I_GQ, I_GK, I_LQ1, I_LK1, I_LQ2, I_LK2, I_GSUB, I_WBR, I_WOUT };

DEV bf16_t f2bf(float f) {
  unsigned u = __float_as_uint(f);
  u += 0x7fffu + ((u >> 16) & 1u);
  return (bf16_t)(u >> 16);
}
DEV float bf2f(bf16_t h) { return __uint_as_float(((unsigned)h) << 16); }
typedef __bf16 bf16x2_t __attribute__((ext_vector_type(2)));
DEV unsigned pack2(float lo, float hi) {
  v2f v = v2f{lo, hi};
  bf16x2_t b = __builtin_convertvector(v, bf16x2_t);
  return __builtin_bit_cast(unsigned, b);
}
DEV float bflo(unsigned u) { return __uint_as_float(u << 16); }
DEV float bfhi(unsigned u) { return __uint_as_float(u & 0xffff0000u); }
DEV float sigm(float x) { return 1.f / (1.f + __expf(-x)); }
DEV float silu(float x) { return x / (1.f + __expf(-x)); }
DEV float wave_sum(float v) {
#pragma unroll
  for (int o = 32; o > 0; o >>= 1) v += __shfl_xor(v, o);
  return v;
}
template <int CTRL> DEV float dppf(float x) {
  return __builtin_bit_cast(float, __builtin_amdgcn_mov_dpp(__builtin_bit_cast(int, x), CTRL, 0xf, 0xf, true));
}
DEV float dpp_sum16(float v) {
  v += dppf<0xB1>(v);
  v += dppf<0x4E>(v);
  v += dppf<0x141>(v);
  v += dppf<0x128>(v);
  return v;
}
DEV int otid() {
  int t = threadIdx.x;
  asm volatile("" : "+v"(t));
  return t;
}
DEV void tokinfo(int m, int& t, int& L) {
  if (m < 4096) { t = m & 255; L = 256; } else { t = (m - 4096) & 2047; L = 2048; }
}
DEV int condof(int m) { return m < 4096 ? 0 : 1 + ((m - 4096) >> 11); }

DEV void transpose_quad(const float* __restrict__ src, bf16_t* __restrict__ dst, int K, int N, int kt, int nq,
                        float* tile) {
  const int tid = otid();
  const int k0 = kt * 64, n0 = nq * 256;
  float v[4][16];
#pragma unroll
  for (int j = 0; j < 4; ++j)
#pragma unroll
    for (int i = 0; i < 16; ++i) {
      int k = i * 4 + (tid >> 6), n = tid & 63;
      v[j][i] = src[(size_t)(k0 + k) * N + n0 + j * 64 + n];
    }
#pragma unroll
  for (int j = 0; j < 4; ++j) {
#pragma unroll
    for (int i = 0; i < 16; ++i) {
      int k = i * 4 + (tid >> 6), n = tid & 63;
      tile[k * 65 + n] = v[j][i];
    }
    __syncthreads();
#pragma unroll
    for (int i = 0; i < 2; ++i) {
      int n = i * 32 + (tid >> 3), oc = (tid & 7) * 8;
      uint4 o;
      o.x = pack2(tile[(oc + 0) * 65 + n], tile[(oc + 1) * 65 + n]);
      o.y = pack2(tile[(oc + 2) * 65 + n], tile[(oc + 3) * 65 + n]);
      o.z = pack2(tile[(oc + 4) * 65 + n], tile[(oc + 5) * 65 + n]);
      o.w = pack2(tile[(oc + 6) * 65 + n], tile[(oc + 7) * 65 + n]);
      *(uint4*)(dst + (size_t)(n0 + j * 64 + n) * K + k0 + oc) = o;
    }
    __syncthreads();
  }
}

DEV void p0_transpose(const Params& p, int idx, float* sm) {
  int l = idx / 752, r = idx % 752;
  if (r < 592) {
    transpose_quad(p.in[I_WIN] + (size_t)l * 1024 * NIN, (bf16_t*)(p.ws + OFF_WTIN) + (size_t)l * NIN * 1024, 1024, NIN,
                   r / 37, r % 37, sm);
  } else if (r < 688) {
    int r2 = r - 592, i = r2 / 32, r3 = r2 % 32;
    transpose_quad(p.in[I_WBR] + (size_t)(l * 3 + i) * 512 * 1024,
                   (bf16_t*)(p.ws + OFF_WTBR) + (size_t)(l * 3 + i) * 1024 * 512, 512, 1024, r3 / 4, r3 % 4, sm);
  } else {
    int r2 = r - 688;
    transpose_quad(p.in[I_WOUT] + (size_t)l * 1024 * 1024, (bf16_t*)(p.ws + OFF_WTOUT) + (size_t)l * 1024 * 1024, 1024,
                   1024, r2 / 4, r2 % 4, sm);
  }
}

DEV void p0_mod(const Params& p, int idx, float* sm) {
  const int tid = otid();
  int l = idx / 48, jb = idx % 48;
  float* sc = sm;
  float* red = sm + 3072;
  for (int e = tid; e < 3072; e += NT) {
    int cond = e >> 10, i = e & 1023;
    float cv = cond == 0 ? p.in[I_CCTX][i] : p.in[I_C][(cond - 1) * 1024 + i];
    sc[e] = silu(cv);
  }
  __syncthreads();
  int jj = tid & 63, ig = tid >> 6;
  int j = jb * 64 + jj;
  const float* w = p.in[I_WADA] + (size_t)l * 1024 * 3072 + j;
  float a0 = 0.f, a1 = 0.f, a2 = 0.f;
#pragma unroll 8
  for (int i = ig * 256; i < ig * 256 + 256; ++i) {
    float wv = w[(size_t)i * 3072];
    a0 += wv * sc[i];
    a1 += wv * sc[1024 + i];
    a2 += wv * sc[2048 + i];
  }
  red[(0 * 4 + ig) * 64 + jj] = a0;
  red[(1 * 4 + ig) * 64 + jj] = a1;
  red[(2 * 4 + ig) * 64 + jj] = a2;
  __syncthreads();
  if (tid < 192) {
    int cond = tid >> 6, q = tid & 63;
    float s = red[(cond * 4 + 0) * 64 + q] + red[(cond * 4 + 1) * 64 + q] + red[(cond * 4 + 2) * 64 + q] +
              red[(cond * 4 + 3) * 64 + q];
    int jo = jb * 64 + q;
    s += p.in[I_BADA][l * 3072 + jo];
    ((float*)(p.ws + OFF_MOD))[(l * 3 + cond) * 3072 + jo] = s;
  }
  __syncthreads();
}

DEV void p0_misc(const Params& p) {
  const int tid = otid();
  float* rope = (float*)(p.ws + OFF_ROPE);
  for (int e = tid; e < 1024; e += NT) {
    int pos = e >> 4, jj = e & 15;
    float fr = powf(10000.0f, -(float)jj / 16.0f);
    float ang = (float)pos * fr;
    rope[e * 2] = cosf(ang);
    rope[e * 2 + 1] = sinf(ang);
  }
  if (tid < 4) {
    int l = tid;
    float s1 = 0.f, s2 = 0.f;
    for (int i = 0; i < 64; ++i) {
      s1 += p.in[I_LQ1][l * 64 + i] * p.in[I_LK1][l * 64 + i];
      s2 += p.in[I_LQ2][l * 64 + i] * p.in[I_LK2][l * 64 + i];
    }
    float li = 0.8f - 0.6f * expf(-0.3f * (float)l);
    float* lam = (float*)(p.ws + OFF_LAM);
    lam[l] = expf(s1) - expf(s2) + li;
    lam[4 + l] = li;
  }
}

DEV void p0_filter(const Params& p, int idx, float* sm) {
  const int tid = otid();
  int l = idx / 288, r = idx % 288;
  int L, d0, rowbase;
  if (r < 32) { L = 256; d0 = r * 8; rowbase = 0; } else { L = 2048; d0 = (r - 32) * 8; rowbase = 512; }
  float* zf = sm;
  float* h1 = sm + 272;
  float* h2 = h1 + 512;
  for (int e = tid; e < 264; e += NT) {
    int pp = e / 33, f = e % 33;
    int d = d0 + pp;
    float val;
    if (f == 0) {
      val = (float)d / (float)(L - 1);
    } else {
      float w = 6.283185307179586f * (float)d / (float)L;
      int bj = (f - 1) & 15;
      float band = 1e-4f + (float)bj * ((15.0f - 1e-4f) / 15.0f);
      float ang = band * w;
      val = (f <= 16) ? cosf(ang) : -sinf(ang);
    }
    zf[pp * 33 + f] = val;
  }
  __syncthreads();
  const float* f1 = p.in[I_HF1] + l * 33 * 64;
  const float* fb1 = p.in[I_HFB1] + l * 64;
  const float* fq = p.in[I_HFREQ] + l * 64;
  const float* f2 = p.in[I_HF2] + l * 64 * 64;
  const float* fb2 = p.in[I_HFB2] + l * 64;
  const float* f3 = p.in[I_HF3] + (size_t)l * 64 * 1024;
#pragma unroll
  for (int q = 0; q < 2; ++q) {
    int v = tid + 256 * q, pp = v >> 6, j = v & 63;
    float s = fb1[j];
#pragma unroll 11
    for (int f = 0; f < 33; ++f) s += zf[pp * 33 + f] * f1[f * 64 + j];
    h1[v] = sinf(fq[j] * s);
  }
  __syncthreads();
#pragma unroll
  for (int q = 0; q < 2; ++q) {
    int v = tid + 256 * q, pp = v >> 6, j = v & 63;
    float s = fb2[j];
#pragma unroll 16
    for (int i = 0; i < 64; ++i) s += h1[pp * 64 + i] * f2[i * 64 + j];
    h2[v] = sinf(fq[j] * s);
  }
  __syncthreads();
  bf16_t* GRb = (bf16_t*)((unsigned*)(p.ws + OFF_G) + (size_t)l * GR_LAYER_DW + (rowbase ? GR_CTX_DW : 0));
  const int CL = 2 * L + 32;
  const float dmin = 3.0701134573253944f, dmax = 15.350567286626972f;
  for (int q = 0; q < 4; ++q) {
    int o = tid + 256 * q;
    float acc[8];
#pragma unroll
    for (int pp = 0; pp < 8; ++pp) acc[pp] = 0.f;
#pragma unroll 8
    for (int j = 0; j < 64; ++j) {
      float wv = f3[j * 1024 + o];
#pragma unroll
      for (int pp = 0; pp < 8; ++pp) acc[pp] += h2[pp * 64 + j] * wv;
    }
    int c = o & 511;
    float delta = dmin + (float)c * ((dmax - dmin) / 511.0f);
    bf16_t* c0 = GRb + (size_t)(c * 2) * CL;
    bf16_t* c1 = c0 + CL;
#pragma unroll
    for (int pp = 0; pp < 8; ++pp) {
      int d = d0 + pp;
      float t = (float)d / (float)(L - 1);
      float val = acc[pp] * __expf(-t * delta);
      if (o < 512) {
        if (d == 0) val += p.in[I_HBIAS][l * 512 + c];
        int qq = L - d;
        bf16_t hv = f2bf(val);
        c0[qq] = hv;
        c1[qq - 1] = hv;
      } else if (d >= 1) {
        int qq = L + d;
        bf16_t hv = f2bf(val);
        c0[qq] = hv;
        c1[qq - 1] = hv;
      }
    }
    if (d0 == 0 && o < 512) {
      c0[0] = 0;
      for (int x = 2 * L; x < CL; ++x) c0[x] = 0;
      for (int x = 2 * L - 1; x < CL; ++x) c1[x] = 0;
    }
  }
  __syncthreads();
}

DEV void norm_item(const Params& p, int l, int idx) {
  const int tid = otid(), lane = tid & 63, wid = tid >> 6;
  float4 v[2][4];
  const float* g = p.in[I_NORMG] + l * 1024;
#pragma unroll
  for (int u = 0; u < 2; ++u) {
    int m = idx * 8 + u * 4 + wid;
    const float* x;
    if (l == 0) x = (m < 4096) ? p.in[I_XP] + (size_t)m * 1024 : p.in[I_XS] + (size_t)(m - 4096) * 1024;
    else x = p.out + (size_t)m * 1024;
#pragma unroll
    for (int i = 0; i < 4; ++i) v[u][i] = *(const float4*)(x + i * 256 + lane * 4);
  }
#pragma unroll
  for (int u = 0; u < 2; ++u) {
    int m = idx * 8 + u * 4 + wid;
    float ss = 0.f;
#pragma unroll
    for (int i = 0; i < 4; ++i)
      ss += v[u][i].x * v[u][i].x + v[u][i].y * v[u][i].y + v[u][i].z * v[u][i].z + v[u][i].w * v[u][i].w;
    ss = wave_sum(ss);
    float rinv = rsqrtf(ss * (1.0f / 1024.0f) + 1e-6f);
    const float* mod = (const float*)(p.ws + OFF_MOD) + (l * 3 + condof(m)) * 3072;
    bf16_t* h = (bf16_t*)(p.ws + OFF_H) + (size_t)m * 1024;
#pragma unroll
    for (int i = 0; i < 4; ++i) {
      int c = i * 256 + lane * 4;
      float4 gg = *(const float4*)(g + c);
      float4 sh = *(const float4*)(mod + c);
      float4 sc = *(const float4*)(mod + 1024 + c);
      float o0 = v[u][i].x * rinv * gg.x * (1.f + sc.x) + sh.x;
      float o1 = v[u][i].y * rinv * gg.y * (1.f + sc.y) + sh.y;
      float o2 = v[u][i].z * rinv * gg.z * (1.f + sc.z) + sh.z;
      float o3 = v[u][i].w * rinv * gg.w * (1.f + sc.w) + sh.w;
      uint2 pk;
      pk.x = pack2(o0, o1);
      pk.y = pack2(o2, o3);
      *(uint2*)(h + c) = pk;
    }
  }
}

template <int MTW>
DEV void gemm_kloop(const bf16_t* __restrict__ Wg, const bf16_t* __restrict__ Xg, int K, f32x4 (&acc)[4][MTW],
                    bf16_t* sm) {
  const int tid = otid(), lane = tid & 63, wid = tid >> 6, wn = wid >> 1, wm = wid & 1, fr = lane & 15,
            fq = lane >> 4;
  constexpr int XR = MTW / 2;
  bf16_t* sW = sm;
  bf16_t* sX = sm + 2 * 5120;
  uint4 rwA0, rwA1, rxA0, rxA1, rwB0, rwB1, rxB0, rxB1, rwC0, rwC1, rxC0, rxC1, rwD0, rwD1, rxD0, rxD1;
  rxA1 = rxB1 = rxC1 = rxD1 = uint4{0u, 0u, 0u, 0u};
  const int r0 = tid >> 2, kc = (tid & 3) * 8;
  const bf16_t* wp = Wg + (size_t)r0 * K + kc;
  const bf16_t* xp = Xg + (size_t)r0 * K + kc;
  const size_t step64 = (size_t)64 * K;
  const bf16_t* cWb = sW + (wn * 64 + fr) * 40 + fq * 8;
  const bf16_t* cXb = sX + (wm * (MTW * 16) + fr) * 40 + fq * 8;
#define GEMM_GL(S, kt_)                                                            \
  {                                                                                \
    const int ko_ = (kt_) * 32;                                                    \
    rw##S##0 = *(const uint4*)(wp + ko_);                                          \
    rw##S##1 = *(const uint4*)(wp + step64 + ko_);                                 \
    rx##S##0 = *(const uint4*)(xp + ko_);                                          \
    if constexpr (XR == 2) rx##S##1 = *(const uint4*)(xp + step64 + ko_);          \
  }
#define GEMM_SW(S, buf_)                                                           \
  {                                                                                \
    bf16_t* dW_ = sW + (buf_) * 5120;                                              \
    bf16_t* dX_ = sX + (buf_) * 5120;                                              \
    *(uint4*)(dW_ + r0 * 40 + kc) = rw##S##0;                                      \
    *(uint4*)(dW_ + (r0 + 64) * 40 + kc) = rw##S##1;                               \
    *(uint4*)(dX_ + r0 * 40 + kc) = rx##S##0;                                      \
    if constexpr (XR == 2) *(uint4*)(dX_ + (r0 + 64) * 40 + kc) = rx##S##1;        \
  }
  auto mma = [&](int buf) {
    const bf16_t* cW = cWb + buf * 5120;
    const bf16_t* cX = cXb + buf * 5120;
    bf16x8 a[4], bb[MTW];
#pragma unroll
    for (int i = 0; i < 4; ++i) a[i] = *(const bf16x8*)(cW + i * 16 * 40);
#pragma unroll
    for (int i = 0; i < MTW; ++i) bb[i] = *(const bf16x8*)(cX + i * 16 * 40);
#pragma unroll
    for (int nt = 0; nt < 4; ++nt)
#pragma unroll
      for (int mt = 0; mt < MTW; ++mt)
        acc[nt][mt] = __builtin_amdgcn_mfma_f32_16x16x32_bf16(a[nt], bb[mt], acc[nt][mt], 0, 0, 0);
  };
  const int nk = K >> 5;
  GEMM_GL(A, 0);
  GEMM_GL(B, 1);
  GEMM_GL(C, 2);
  GEMM_GL(D, 3);
  GEMM_SW(A, 0);
  __syncthreads();
  for (int kt = 0; kt < nk; kt += 4) {
    const bool more4 = (kt + 4 < nk);
    if (more4) GEMM_GL(A, kt + 4);
    mma(0);
    GEMM_SW(B, 1);
    __syncthreads();
    if (more4) GEMM_GL(B, kt + 5);
    mma(1);
    GEMM_SW(C, 0);
    __syncthreads();
    if (more4) GEMM_GL(C, kt + 6);
    mma(0);
    GEMM_SW(D, 1);
    __syncthreads();
    if (more4) GEMM_GL(D, kt + 7);
    mma(1);
    if (more4) GEMM_SW(A, 0);
    __syncthreads();
  }
#undef GEMM_GL
#undef GEMM_SW
}

DEV void gemm_in_tile(const Params& p, int l, int tile, bf16_t* sm) {
  const int tid = otid(), lane = tid & 63, wid = tid >> 6, wn = wid >> 1, wm = wid & 1, fr = lane & 15,
            fq = lane >> 4;
  int mt_ = tile & 63, nt_ = tile >> 6;
  int m0 = mt_ * 128, n0 = nt_ * 128;
  f32x4 acc[4][4];
#pragma unroll
  for (int a = 0; a < 4; ++a)
#pragma unroll
    for (int b = 0; b < 4; ++b) acc[a][b] = f32x4{0.f, 0.f, 0.f, 0.f};
  const bf16_t* Wt = (const bf16_t*)(p.ws + OFF_WTIN) + ((size_t)l * NIN + n0) * 1024;
  const bf16_t* X = (const bf16_t*)(p.ws + OFF_H) + (size_t)m0 * 1024;
  gemm_kloop<4>(Wt, X, 1024, acc, sm);
  bf16_t* z = (bf16_t*)(p.ws + OFF_Z);
#pragma unroll
  for (int nt = 0; nt < 4; ++nt)
#pragma unroll
    for (int mt = 0; mt < 4; ++mt) {
      int n = n0 + wn * 64 + nt * 16 + fq * 4;
      int m = m0 + wm * 64 + mt * 16 + fr;
      uint2 pk;
      pk.x = pack2(acc[nt][mt][0], acc[nt][mt][1]);
      pk.y = pack2(acc[nt][mt][2], acc[nt][mt][3]);
      *(uint2*)(z + (size_t)m * NIN + n) = pk;
    }
}

DEV void gemm_br_tile(const Params& p, int l, int tile, bf16_t* sm) {
  const int tid = otid(), lane = tid & 63, wid = tid >> 6, wn = wid >> 1, wm = wid & 1, fr = lane & 15,
            fq = lane >> 4;
  int mt_ = tile & 127, nt_ = tile >> 7;
  int m0 = mt_ * 64, n0 = nt_ * 128;
  f32x4 tot[4][2];
#pragma unroll
  for (int a = 0; a < 4; ++a)
#pragma unroll
    for (int b = 0; b < 2; ++b) tot[a][b] = f32x4{0.f, 0.f, 0.f, 0.f};
  const bf16_t* z = (const bf16_t*)(p.ws + OFF_Z);
#pragma unroll 1
  for (int br = 0; br < 3; ++br) {
    asm volatile("" ::: "memory");
    f32x4 acc[4][2];
#pragma unroll
    for (int a = 0; a < 4; ++a)
#pragma unroll
      for (int b = 0; b < 2; ++b) acc[a][b] = f32x4{0.f, 0.f, 0.f, 0.f};
    const bf16_t* Wt = (const bf16_t*)(p.ws + OFF_WTBR) + ((size_t)(l * 3 + br) * 1024 + n0) * 512;
    const bf16_t* X = (const bf16_t*)(p.ws + OFF_YA + (size_t)br * MTOK * 512 * 2) + (size_t)m0 * 512;
    gemm_kloop<2>(Wt, X, 512, acc, sm);
#pragma unroll
    for (int nt = 0; nt < 4; ++nt)
#pragma unroll
      for (int mt = 0; mt < 2; ++mt) {
        int n = n0 + wn * 64 + nt * 16 + fq * 4;
        int m = m0 + wm * 32 + mt * 16 + fr;
        uint2 g = *(const uint2*)(z + (size_t)m * NIN + C_MG + br * 1024 + n);
        tot[nt][mt][0] += sigm(bflo(g.x)) * acc[nt][mt][0];
        tot[nt][mt][1] += sigm(bfhi(g.x)) * acc[nt][mt][1];
        tot[nt][mt][2] += sigm(bflo(g.y)) * acc[nt][mt][2];
        tot[nt][mt][3] += sigm(bfhi(g.y)) * acc[nt][mt][3];
      }
  }
  bf16_t* mg = (bf16_t*)(p.ws + OFF_H);
#pragma unroll
  for (int nt = 0; nt < 4; ++nt)
#pragma unroll
    for (int mt = 0; mt < 2; ++mt) {
      int n = n0 + wn * 64 + nt * 16 + fq * 4;
      int m = m0 + wm * 32 + mt * 16 + fr;
      uint2 pk;
      pk.x = pack2(tot[nt][mt][0], tot[nt][mt][1]);
      pk.y = pack2(tot[nt][mt][2], tot[nt][mt][3]);
      *(uint2*)(mg + (size_t)m * 1024 + n) = pk;
    }
}

DEV void gemm_out_tile(const Params& p, int l, int tile, bf16_t* sm) {
  const int tid = otid(), lane = tid & 63, wid = tid >> 6, wn = wid >> 1, wm = wid & 1, fr = lane & 15,
            fq = lane >> 4;
  int mt_ = tile & 63, nt_ = tile >> 6;
  int m0 = mt_ * 128, n0 = nt_ * 128;
  f32x4 acc[4][4];
#pragma unroll
  for (int a = 0; a < 4; ++a)
#pragma unroll
    for (int b = 0; b < 4; ++b) acc[a][b] = f32x4{0.f, 0.f, 0.f, 0.f};
  const bf16_t* Wt = (const bf16_t*)(p.ws + OFF_WTOUT) + ((size_t)l * 1024 + n0) * 1024;
  const bf16_t* X = (const bf16_t*)(p.ws + OFF_H) + (size_t)m0 * 1024;
  gemm_kloop<4>(Wt, X, 1024, acc, sm);
  const float* gate = (const float*)(p.ws + OFF_MOD) + (l * 3 + condof(m0)) * 3072 + 2048;
#pragma unroll
  for (int nt = 0; nt < 4; ++nt)
#pragma unroll
    for (int mt = 0; mt < 4; ++mt) {
      int n = n0 + wn * 64 + nt * 16 + fq * 4;
      int m = m0 + wm * 64 + mt * 16 + fr;
      const float* xin;
      if (l == 0) xin = (m < 4096) ? p.in[I_XP] + (size_t)m * 1024 : p.in[I_XS] + (size_t)(m - 4096) * 1024;
      else xin = p.out + (size_t)m * 1024;
      float4 xv = *(const float4*)(xin + n);
      float4 gv = *(const float4*)(gate + n);
      float4 o;
      o.x = xv.x + gv.x * acc[nt][mt][0];
      o.y = xv.y + gv.y * acc[nt][mt][1];
      o.z = xv.z + gv.z * acc[nt][mt][2];
      o.w = xv.w + gv.w * acc[nt][mt][3];
      *(float4*)(p.out + (size_t)m * 1024 + n) = o;
    }
}

DEV void prep_hyena(const Params& p, int l, int idx) {
  const int tid = otid();
  const int c2 = tid * 2;
  const bf16_t* z = (const bf16_t*)(p.ws + OFF_Z);
  const float* cw = p.in[I_HCW] + l * 3 * 1536;
  const float* cb = p.in[I_HCB] + l * 1536;
  bf16_t* ut = (bf16_t*)(p.ws + OFF_H);
  float* x1b = (float*)(p.ws + OFF_X1);
  v2f w0[3], w1[3], w2[3], bb[3];
#pragma unroll
  for (int pt = 0; pt < 3; ++pt) {
    int col = pt * 512 + c2;
    w0[pt] = *(const v2f*)(cw + col);
    w1[pt] = *(const v2f*)(cw + 1536 + col);
    w2[pt] = *(const v2f*)(cw + 3072 + col);
    bb[pt] = *(const v2f*)(cb + col);
  }
  const int m0 = idx * 16;
  unsigned ua[8], ub[8];
  v2f x1r[16];
  float pa = 0.f, pb = 0.f;
#pragma unroll
  for (int i = 0; i < 16; ++i) {
    int m = m0 + i, t, L;
    tokinfo(m, t, L);
    v2f u[3];
#pragma unroll
    for (int pt = 0; pt < 3; ++pt) {
      int col = C_HYZ + pt * 512 + c2;
      unsigned z0 = *(const unsigned*)(z + (size_t)m * NIN + col);
      unsigned zm = (t > 0) ? *(const unsigned*)(z + (size_t)(m - 1) * NIN + col) : 0u;
      unsigned zp = (t < L - 1) ? *(const unsigned*)(z + (size_t)(m + 1) * NIN + col) : 0u;
      v2f a = v2f{bflo(zm), bfhi(zm)}, b = v2f{bflo(z0), bfhi(z0)}, c = v2f{bflo(zp), bfhi(zp)};
      u[pt] = a * w0[pt] + b * w1[pt] + c * w2[pt] + bb[pt];
    }
    v2f uu = u[2] * u[0];
    x1r[i] = u[1];
    if (i & 1) {
      ua[i >> 1] = pack2(pa, uu.x);
      ub[i >> 1] = pack2(pb, uu.y);
    } else {
      pa = uu.x;
      pb = uu.y;
    }
  }
#pragma unroll
  for (int i = 0; i < 16; ++i) *(v2f*)(x1b + (size_t)(m0 + i) * 512 + c2) = x1r[i];
  bf16_t* d0 = ut + (size_t)c2 * MTOK + m0;
  bf16_t* d1 = d0 + MTOK;
  *(uint4*)(d0) = uint4{ua[0], ua[1], ua[2], ua[3]};
  *(uint4*)(d0 + 8) = uint4{ua[4], ua[5], ua[6], ua[7]};
  *(uint4*)(d1) = uint4{ub[0], ub[1], ub[2], ub[3]};
  *(uint4*)(d1 + 8) = uint4{ub[4], ub[5], ub[6], ub[7]};
}

DEV float zr_mix(const bf16_t* z, const float* mu, int m, int t, int L, int cc) {
  int col = C_RWZ + cc;
  float z0 = bf2f(z[(size_t)m * NIN + col]);
  float zm = (t > 0) ? bf2f(z[(size_t)(m - 1) * NIN + col]) : 0.f;
  float zp = (t < L - 1) ? bf2f(z[(size_t)(m + 1) * NIN + col]) : 0.f;
  return z0 + mu[cc] * (0.5f * (zm + zp) - z0);
}

DEV void prep_rwkv(const Params& p, int l, int idx, float* sm) {
  const int tid = otid();
  const bf16_t* z = (const bf16_t*)(p.ws + OFF_Z);
  const float* mu = p.in[I_RMU] + l * 1792;
  const int m0 = idx * 8;
  float* lora = sm;
  {
    int tk = tid >> 5, cc0 = (tid & 31) * 8;
    int m = m0 + tk, t, L;
    tokinfo(m, t, L);
#pragma unroll
    for (int e = 0; e < 8; ++e) {
      int cc = cc0 + e;
      float val = zr_mix(z, mu, m, t, L, 1536 + cc);
      int type = cc >> 6, j = cc & 63;
      if (type < 2) val = tanhf(val);
      lora[(j * 4 + type) * 8 + tk] = val;
    }
  }
  __syncthreads();
  float* R = (float*)(p.ws + OFF_R);
  float* KK = (float*)(p.ws + OFF_KK);
  float* V = (float*)(p.ws + OFF_V);
  float* W = (float*)(p.ws + OFF_W);
  float* BV = (float*)(p.ws + OFF_BV);
  float* KD = (float*)(p.ws + OFF_KD);
  const size_t DSTR = (size_t)MTOK * 512;
  float acc[2][4][8];
#pragma unroll
  for (int s = 0; s < 2; ++s)
#pragma unroll
    for (int ty = 0; ty < 4; ++ty)
#pragma unroll
      for (int tk = 0; tk < 8; ++tk) acc[s][ty][tk] = 0.f;
  {
    const float* w2 = p.in[I_RW2] + (size_t)l * 2 * 64 * 512 + tid;
    const float* a2 = p.in[I_RA2] + (size_t)l * 2 * 64 * 512 + tid;
#pragma unroll 4
    for (int j = 0; j < 64; ++j) {
      float wv[2][4];
#pragma unroll
      for (int s = 0; s < 2; ++s) {
        wv[s][0] = w2[j * 512 + 256 * s];
        wv[s][1] = w2[(64 + j) * 512 + 256 * s];
        wv[s][2] = a2[j * 512 + 256 * s];
        wv[s][3] = a2[(64 + j) * 512 + 256 * s];
      }
#pragma unroll
      for (int ty = 0; ty < 4; ++ty) {
        float4 l0 = *(const float4*)(lora + (j * 4 + ty) * 8);
        float4 l1 = *(const float4*)(lora + (j * 4 + ty) * 8 + 4);
#pragma unroll
        for (int s = 0; s < 2; ++s) {
          acc[s][ty][0] += l0.x * wv[s][ty];
          acc[s][ty][1] += l0.y * wv[s][ty];
          acc[s][ty][2] += l0.z * wv[s][ty];
          acc[s][ty][3] += l0.w * wv[s][ty];
          acc[s][ty][4] += l1.x * wv[s][ty];
          acc[s][ty][5] += l1.y * wv[s][ty];
          acc[s][ty][6] += l1.z * wv[s][ty];
          acc[s][ty][7] += l1.w * wv[s][ty];
        }
      }
    }
  }
#pragma unroll
  for (int s = 0; s < 2; ++s) {
    int c = tid + 256 * s;
    float rr[8], kr[8], vr[8];
#pragma unroll
    for (int tk = 0; tk < 8; ++tk) {
      int m = m0 + tk, t, L;
      tokinfo(m, t, L);
      rr[tk] = zr_mix(z, mu, m, t, L, c);
      kr[tk] = zr_mix(z, mu, m, t, L, 512 + c);
      vr[tk] = zr_mix(z, mu, m, t, L, 1024 + c);
    }
    float w00 = p.in[I_RW0][(l * 2 + 0) * 512 + c], w01 = p.in[I_RW0][(l * 2 + 1) * 512 + c];
    float a00 = p.in[I_RA0][(l * 2 + 0) * 512 + c], a01 = p.in[I_RA0][(l * 2 + 1) * 512 + c];
    float kkw = p.in[I_RKK][l * 512 + c], kaw = p.in[I_RKA][l * 512 + c];
#pragma unroll
    for (int tk = 0; tk < 8; ++tk) {
      int m = m0 + tk;
      float r = rr[tk], k = kr[tk], v = vr[tk];
      float kk = k * kkw;
      float ss = wave_sum(kk * kk);
      kk = kk * rsqrtf(ss + 1e-12f);
      float wd0 = __expf(-0.6065306597126334f * sigm(w00 + acc[s][0][tk]));
      float wd1 = __expf(-0.6065306597126334f * sigm(w01 + acc[s][1][tk]));
      float ad0 = sigm(a00 + acc[s][2][tk]);
      float ad1 = sigm(a01 + acc[s][3][tk]);
      size_t o = (size_t)m * 512 + c;
      R[o] = r;
      KK[o] = kk;
      V[o] = v;
      W[o] = wd0;
      W[DSTR + o] = wd1;
      BV[o] = kk * ad0;
      BV[DSTR + o] = kk * ad1;
      KD[o] = k * (1.f + (ad0 - 1.f) * kaw);
      KD[DSTR + o] = k * (1.f + (ad1 - 1.f) * kaw);
    }
  }
  __syncthreads();
}

DEV void prep_qk(const Params& p, int l, int idx) {
  const int tid = otid();
  int gid = idx * 256 + tid;
  int m = gid >> 4, chunk = gid & 15;
  const bool isk = chunk >= 8;
  const int ch8 = chunk & 7;
  const bf16_t* z = (const bf16_t*)(p.ws + OFF_Z) + (size_t)m * NIN + (isk ? C_DAK : C_DAQ) + ch8 * 64;
  float x[64];
  float ss = 0.f;
#pragma unroll
  for (int i = 0; i < 8; ++i) {
    uint4 u = *(const uint4*)(z + i * 8);
    x[i * 8 + 0] = bflo(u.x); x[i * 8 + 1] = bfhi(u.x);
    x[i * 8 + 2] = bflo(u.y); x[i * 8 + 3] = bfhi(u.y);
    x[i * 8 + 4] = bflo(u.z); x[i * 8 + 5] = bfhi(u.z);
    x[i * 8 + 6] = bflo(u.w); x[i * 8 + 7] = bfhi(u.w);
  }
#pragma unroll
  for (int i = 0; i < 64; ++i) ss += x[i] * x[i];
  float rinv = rsqrtf(ss * (1.0f / 64.0f) + 1e-6f);
  const float* g = (isk ? p.in[I_GK] : p.in[I_GQ]) + l * 64;
#pragma unroll
  for (int i = 0; i < 64; ++i) x[i] = x[i] * rinv * g[i];
  int t, L;
  tokinfo(m, t, L);
  if (m < 4096) {
    if (isk) {
      int b = m >> 8;
      float* ck = p.out + O_CK + ((size_t)(b * 4 + l) * 256 + t) * 512 + ch8 * 64;
#pragma unroll
      for (int i = 0; i < 16; ++i) *(float4*)(ck + i * 4) = float4{x[i * 4], x[i * 4 + 1], x[i * 4 + 2], x[i * 4 + 3]};
    }
  } else {
    const float* rope = (const float*)(p.ws + OFF_ROPE);
    int row = t >> 6, colp = t & 63;
#pragma unroll
    for (int jj = 0; jj < 16; ++jj) {
      float c1 = rope[(row * 16 + jj) * 2], s1 = rope[(row * 16 + jj) * 2 + 1];
      float a = x[jj], b = x[16 + jj];
      x[jj] = a * c1 - b * s1;
      x[16 + jj] = a * s1 + b * c1;
      float c2 = rope[(colp * 16 + jj) * 2], s2 = rope[(colp * 16 + jj) * 2 + 1];
      float a2 = x[32 + jj], b2 = x[48 + jj];
      x[32 + jj] = a2 * c2 - b2 * s2;
      x[48 + jj] = a2 * s2 + b2 * c2;
    }
  }
  bf16_t* dst;
  if (!isk) {
#pragma unroll
    for (int i = 0; i < 64; ++i) x[i] *= 0.18033688011112042f;
    dst = (bf16_t*)(p.ws + OFF_Q) + (size_t)m * 512 + ch8 * 64;
  } else {
    size_t krow = (m < 4096) ? (size_t)m : (size_t)4096 + (size_t)((m - 4096) >> 11) * 2304 + 256 + t;
    dst = (bf16_t*)(p.ws + OFF_K) + krow * 512 + ch8 * 64;
  }
#pragma unroll
  for (int i = 0; i < 8; ++i) {
    uint4 u;
    u.x = pack2(x[i * 8 + 0], x[i * 8 + 1]);
    u.y = pack2(x[i * 8 + 2], x[i * 8 + 3]);
    u.z = pack2(x[i * 8 + 4], x[i * 8 + 5]);
    u.w = pack2(x[i * 8 + 6], x[i * 8 + 7]);
    *(uint4*)(dst + i * 8) = u;
  }
}

DEV void prep_kcache(const Params& p, int l, int idx) {
  const int tid = otid();
  int gid = idx * 256 + tid;
  int b = gid >> 11, pp = (gid >> 3) & 255, ch8 = gid & 7;
  const float* src = p.in[I_CK] + ((size_t)(b * 4 + l) * 256 + pp) * 512 + ch8 * 64;
  bf16_t* dst = (bf16_t*)(p.ws + OFF_K) + ((size_t)4096 + (size_t)b * 2304 + pp) * 512 + ch8 * 64;
#pragma unroll
  for (int i = 0; i < 8; ++i) {
    float4 a = *(const float4*)(src + i * 8), c = *(const float4*)(src + i * 8 + 4);
    uint4 u;
    u.x = pack2(a.x, a.y); u.y = pack2(a.z, a.w); u.z = pack2(c.x, c.y); u.w = pack2(c.z, c.w);
    *(uint4*)(dst + i * 8) = u;
  }
}

DEV void prep_vt(const Params& p, int l, int idx, bf16_t* sv) {
  const int tid = otid();
  int h, kt, Lk;
  bf16_t* vt;
  const int i = tid >> 2, dq = (tid & 3) * 32;
  bf16_t* srow = sv + i * 136 + dq;
  if (idx < 256) {
    int seq = idx >> 4;
    h = (idx >> 2) & 3; kt = idx & 3; Lk = 256;
    vt = (bf16_t*)(p.ws + OFF_VT) + (size_t)(seq * 4 + h) * 128 * 256;
    int t = kt * 64 + i;
    int m = seq * 256 + t;
    const bf16_t* src = (const bf16_t*)(p.ws + OFF_Z) + (size_t)m * NIN + C_DAV + h * 128 + dq;
    float* cv = p.out + O_CV + ((size_t)(seq * 4 + l) * 256 + t) * 512 + h * 128 + dq;
#pragma unroll
    for (int e = 0; e < 4; ++e) {
      uint4 u = *(const uint4*)(src + e * 8);
      *(uint4*)(srow + e * 8) = u;
      *(float4*)(cv + e * 8) = float4{bflo(u.x), bfhi(u.x), bflo(u.y), bfhi(u.y)};
      *(float4*)(cv + e * 8 + 4) = float4{bflo(u.z), bfhi(u.z), bflo(u.w), bfhi(u.w)};
    }
  } else {
    int r = idx - 256;
    int b = r / 144;
    h = (r / 36) & 3; kt = r % 36; Lk = 2304;
    vt = (bf16_t*)(p.ws + OFF_VT) + (size_t)4096 * 512 + (size_t)(b * 4 + h) * 128 * 2304;
    if (kt < 4) {
      const float* src = p.in[I_CV] + ((size_t)(b * 4 + l) * 256 + kt * 64 + i) * 512 + h * 128 + dq;
#pragma unroll
      for (int e = 0; e < 4; ++e) {
        float4 a = *(const float4*)(src + e * 8), c = *(const float4*)(src + e * 8 + 4);
        uint4 u;
        u.x = pack2(a.x, a.y); u.y = pack2(a.z, a.w); u.z = pack2(c.x, c.y); u.w = pack2(c.z, c.w);
        *(uint4*)(srow + e * 8) = u;
      }
    } else {
      int m = 4096 + b * 2048 + (kt - 4) * 64 + i;
      const bf16_t* src = (const bf16_t*)(p.ws + OFF_Z) + (size_t)m * NIN + C_DAV + h * 128 + dq;
#pragma unroll
      for (int e = 0; e < 4; ++e) *(uint4*)(srow + e * 8) = *(const uint4*)(src + e * 8);
    }
  }
  __syncthreads();
  {
    int d = tid >> 1, half = tid & 1;
    bf16_t* dst = vt + (size_t)d * Lk + kt * 64 + half * 32;
#pragma unroll
    for (int e = 0; e < 4; ++e) {
      unsigned w[4];
#pragma unroll
      for (int q = 0; q < 4; ++q) {
        int k0 = half * 32 + e * 8 + q * 2;
        w[q] = (unsigned)sv[k0 * 136 + d] | ((unsigned)sv[(k0 + 1) * 136 + d] << 16);
      }
      *(uint4*)(dst + e * 8) = uint4{w[0], w[1], w[2], w[3]};
    }
  }
  __syncthreads();
}

DEV void scan_item(const Params& p, int l, int seqbase, int L, int b, bool is_ctx, int h, int d, int rq, float* sb) {
  const int tid = otid();
  const int vl = tid >> 4, kq = tid & 15;
  const int v = rq * 16 + vl;
  const size_t DSTR = (size_t)MTOK * 512;
  const float* W = (const float*)(p.ws + OFF_W) + d * DSTR;
  const float* BV = (const float*)(p.ws + OFF_BV) + d * DSTR;
  const float* KD = (const float*)(p.ws + OFF_KD) + d * DSTR;
  const float* KK = (const float*)(p.ws + OFF_KK);
  const float* R = (const float*)(p.ws + OFF_R);
  const float* V = (const float*)(p.ws + OFF_V);
  float* Y = (float*)(p.ws + OFF_Y) + d * DSTR;
  float4 S = float4{0.f, 0.f, 0.f, 0.f};
  if (!is_ctx) S = *(const float4*)(p.in[I_ST] + ((((size_t)(b * 4 + l) * 2 + d) * 8 + h) * 64 + v) * 64 + kq * 4);
  const int nch = L >> 4;
  float4 g0, g1, g2, g3, g4;
  float gv;
  {
    int sidx = vl;
    int t = d ? (L - 1 - sidx) : sidx;
    size_t m = (size_t)(seqbase + t);
    size_t off = m * 512 + h * 64 + kq * 4;
    g0 = *(const float4*)(W + off); g1 = *(const float4*)(KK + off); g2 = *(const float4*)(BV + off);
    g3 = *(const float4*)(KD + off); g4 = *(const float4*)(R + off);
    gv = V[m * 512 + h * 64 + rq * 16 + kq];
    float* dst = sb + vl * 336;
    *(float4*)(dst + kq * 4) = g0; *(float4*)(dst + 64 + kq * 4) = g1; *(float4*)(dst + 128 + kq * 4) = g2;
    *(float4*)(dst + 192 + kq * 4) = g3; *(float4*)(dst + 256 + kq * 4) = g4;
    dst[320 + kq] = gv;
  }
  __syncthreads();
  for (int c = 0; c < nch; ++c) {
    const bool more = (c + 1 < nch);
    if (more) {
      int sidx = (c + 1) * 16 + vl;
      int t = d ? (L - 1 - sidx) : sidx;
      size_t m = (size_t)(seqbase + t);
      size_t off = m * 512 + h * 64 + kq * 4;
      g0 = *(const float4*)(W + off); g1 = *(const float4*)(KK + off); g2 = *(const float4*)(BV + off);
      g3 = *(const float4*)(KD + off); g4 = *(const float4*)(R + off);
      gv = V[m * 512 + h * 64 + rq * 16 + kq];
    }
    const float* cur = sb + (c & 1) * (16 * 336);
    float ykeep = 0.f;
    float4 nw = *(const float4*)(cur + kq * 4);
    float4 nkk = *(const float4*)(cur + 64 + kq * 4);
    float4 nbv = *(const float4*)(cur + 128 + kq * 4);
    float4 nkd = *(const float4*)(cur + 192 + kq * 4);
    float4 nr = *(const float4*)(cur + 256 + kq * 4);
    float nvv = cur[320 + vl];
#pragma unroll
    for (int i = 0; i < 16; ++i) {
      const float4 w = nw, kk = nkk, bv = nbv, kd = nkd, r = nr;
      const float vv = nvv;
      if (i + 1 < 16) {
        const float* row = cur + (i + 1) * 336;
        nw = *(const float4*)(row + kq * 4);
        nkk = *(const float4*)(row + 64 + kq * 4);
        nbv = *(const float4*)(row + 128 + kq * 4);
        nkd = *(const float4*)(row + 192 + kq * 4);
        nr = *(const float4*)(row + 256 + kq * 4);
        nvv = row[320 + vl];
      }
      __builtin_amdgcn_sched_barrier(0);
      v2f pd = v2f{S.x, S.y} * v2f{kk.x, kk.y};
      pd = v2f{S.z, S.w} * v2f{kk.z, kk.w} + pd;
      float dot = dpp_sum16(pd.x + pd.y);
      S.x = S.x * w.x + vv * kd.x - dot * bv.x;
      S.y = S.y * w.y + vv * kd.y - dot * bv.y;
      S.z = S.z * w.z + vv * kd.z - dot * bv.z;
      S.w = S.w * w.w + vv * kd.w - dot * bv.w;
      v2f py = v2f{S.x, S.y} * v2f{r.x, r.y};
      py = v2f{S.z, S.w} * v2f{r.z, r.w} + py;
      float y = dpp_sum16(py.x + py.y);
      ykeep = (kq == i) ? y : ykeep;
      __builtin_amdgcn_sched_barrier(0);
    }
    {
      int sidx = c * 16 + kq;
      int t = d ? (L - 1 - sidx) : sidx;
      Y[(size_t)(seqbase + t) * 512 + h * 64 + v] = ykeep;
    }
    if (more) {
      float* dst = sb + ((c + 1) & 1) * (16 * 336) + vl * 336;
      *(float4*)(dst + kq * 4) = g0; *(float4*)(dst + 64 + kq * 4) = g1; *(float4*)(dst + 128 + kq * 4) = g2;
      *(float4*)(dst + 192 + kq * 4) = g3; *(float4*)(dst + 256 + kq * 4) = g4;
      dst[320 + kq] = gv;
    }
    __syncthreads();
  }
  if (is_ctx) {
    *(float4*)(p.out + O_ST + ((((size_t)(b * 4 + l) * 2 + d) * 8 + h) * 64 + v) * 64 + kq * 4) = S;
  }
}

DEV void attn_item(const Params& p, int l, int seqbase, int qt, int h, size_t krow0, int Lk, const bf16_t* vt,
                   bf16_t* sm) {
  const int tid = otid(), lane = tid & 63, wid = tid >> 6, fr = lane & 15, fq = lane >> 4;
  bf16_t* sK = sm;
  bf16_t* sV = sm + 64 * 136;
  const bf16_t* Kg = (const bf16_t*)(p.ws + OFF_K) + krow0 * 512 + h * 128;
  const int q0 = seqbase + qt * 64 + wid * 16;
  const bf16_t* Qg = (const bf16_t*)(p.ws + OFF_Q) + (size_t)(q0 + fr) * 512 + h * 128;
  bf16x8 qf[2][2];
#pragma unroll
  for (int mp = 0; mp < 2; ++mp)
#pragma unroll
    for (int ch = 0; ch < 2; ++ch) qf[mp][ch] = *(const bf16x8*)(Qg + mp * 64 + ch * 32 + fq * 8);
  f32x4 O[2][8];
#pragma unroll
  for (int mp = 0; mp < 2; ++mp)
#pragma unroll
    for (int dt = 0; dt < 8; ++dt) O[mp][dt] = f32x4{0.f, 0.f, 0.f, 0.f};
  float ls0 = 0.f, ls1 = 0.f;
  const int nkt = Lk >> 6;
  const int a_kr = tid >> 4, a_kc = (tid & 15) * 8;
  const int a_vr = tid >> 3, a_vc = (tid & 7) * 8;
  const bf16_t* kgp = Kg + (size_t)a_kr * 512 + a_kc;
  const bf16_t* vgp = vt + (size_t)a_vr * Lk + a_vc;
  uint4 pk0, pk1, pk2, pk3, pv0, pv1, pv2, pv3;
  pk0 = *(const uint4*)(kgp);
  pk1 = *(const uint4*)(kgp + (size_t)16 * 512);
  pk2 = *(const uint4*)(kgp + (size_t)32 * 512);
  pk3 = *(const uint4*)(kgp + (size_t)48 * 512);
  pv0 = *(const uint4*)(vgp);
  pv1 = *(const uint4*)(vgp + (size_t)32 * Lk);
  pv2 = *(const uint4*)(vgp + (size_t)64 * Lk);
  pv3 = *(const uint4*)(vgp + (size_t)96 * Lk);
  for (int kt = 0; kt < nkt; ++kt) {
    {
      bf16_t* dk = sK + a_kr * 136 + a_kc;
      *(uint4*)(dk) = pk0;
      *(uint4*)(dk + 16 * 136) = pk1;
      *(uint4*)(dk + 32 * 136) = pk2;
      *(uint4*)(dk + 48 * 136) = pk3;
      bf16_t* dv = sV + a_vr * 72 + a_vc;
      *(uint4*)(dv) = pv0;
      *(uint4*)(dv + 32 * 72) = pv1;
      *(uint4*)(dv + 64 * 72) = pv2;
      *(uint4*)(dv + 96 * 72) = pv3;
    }
    __syncthreads();
    if (kt + 1 < nkt) {
      const bf16_t* kn = kgp + (size_t)(kt + 1) * 64 * 512;
      const bf16_t* vn = vgp + (kt + 1) * 64;
      pk0 = *(const uint4*)(kn);
      pk1 = *(const uint4*)(kn + (size_t)16 * 512);
      pk2 = *(const uint4*)(kn + (size_t)32 * 512);
      pk3 = *(const uint4*)(kn + (size_t)48 * 512);
      pv0 = *(const uint4*)(vn);
      pv1 = *(const uint4*)(vn + (size_t)32 * Lk);
      pv2 = *(const uint4*)(vn + (size_t)64 * Lk);
      pv3 = *(const uint4*)(vn + (size_t)96 * Lk);
    }
    f32x4 s[2][4];
#pragma unroll
    for (int k16 = 0; k16 < 4; ++k16)
#pragma unroll
      for (int mp = 0; mp < 2; ++mp) {
        f32x4 a = f32x4{0.f, 0.f, 0.f, 0.f};
#pragma unroll
        for (int ch = 0; ch < 2; ++ch) {
          bf16x8 kf = *(const bf16x8*)(sK + (k16 * 16 + fr) * 136 + mp * 64 + ch * 32 + fq * 8);
          a = __builtin_amdgcn_mfma_f32_16x16x32_bf16(kf, qf[mp][ch], a, 0, 0, 0);
        }
        s[mp][k16] = a;
      }
    bf16x8 pf[2][2];
#pragma unroll
    for (int mp = 0; mp < 2; ++mp) {
      float lsum = 0.f;
#pragma unroll
      for (int k16 = 0; k16 < 4; ++k16)
#pragma unroll
        for (int j = 0; j < 4; ++j) {
          float e = __builtin_amdgcn_exp2f(s[mp][k16][j]);
          s[mp][k16][j] = e;
          lsum += e;
        }
      if (mp == 0) ls0 += lsum; else ls1 += lsum;
#pragma unroll
      for (int g = 0; g < 2; ++g) {
        uint4 fu;
        fu.x = pack2(s[mp][2 * g][0], s[mp][2 * g][1]);
        fu.y = pack2(s[mp][2 * g][2], s[mp][2 * g][3]);
        fu.z = pack2(s[mp][2 * g + 1][0], s[mp][2 * g + 1][1]);
        fu.w = pack2(s[mp][2 * g + 1][2], s[mp][2 * g + 1][3]);
        pf[mp][g] = __builtin_bit_cast(bf16x8, fu);
      }
    }
#pragma unroll
    for (int dt = 0; dt < 8; ++dt)
#pragma unroll
      for (int g = 0; g < 2; ++g) {
        const bf16_t* vp = sV + (dt * 16 + fr) * 72 + g * 32 + fq * 4;
        uint2 lo = *(const uint2*)(vp);
        uint2 hi = *(const uint2*)(vp + 16);
        uint4 u = uint4{lo.x, lo.y, hi.x, hi.y};
        bf16x8 vf = __builtin_bit_cast(bf16x8, u);
        O[0][dt] = __builtin_amdgcn_mfma_f32_16x16x32_bf16(vf, pf[0][g], O[0][dt], 0, 0, 0);
        O[1][dt] = __builtin_amdgcn_mfma_f32_16x16x32_bf16(vf, pf[1][g], O[1][dt], 0, 0, 0);
      }
    __syncthreads();
  }
  ls0 += __shfl_xor(ls0, 16); ls0 += __shfl_xor(ls0, 32);
  ls1 += __shfl_xor(ls1, 16); ls1 += __shfl_xor(ls1, 32);
  const float* lamp = (const float*)(p.ws + OFF_LAM);
  const float lam = lamp[l], lam_init = lamp[4 + l];
  const float i0 = 1.f / ls0, i1 = lam / ls1;
  float ss = 0.f;
#pragma unroll
  for (int dt = 0; dt < 8; ++dt)
#pragma unroll
    for (int j = 0; j < 4; ++j) {
      float o = O[0][dt][j] * i0 - O[1][dt][j] * i1;
      O[0][dt][j] = o;
      ss += o * o;
    }
  ss += __shfl_xor(ss, 16); ss += __shfl_xor(ss, 32);
  const float rinv = rsqrtf(ss * (1.0f / 128.0f) + 1e-5f) * (1.f - lam_init);
  const int m = q0 + fr;
  const bf16_t* zg = (const bf16_t*)(p.ws + OFF_Z) + (size_t)m * NIN + C_DAG + h * 128;
  bf16_t* yc = (bf16_t*)(p.ws + OFF_YC) + (size_t)m * 512 + h * 128;
  const float* gsub = p.in[I_GSUB] + l * 128;
#pragma unroll
  for (int dt = 0; dt < 8; ++dt) {
    int dd = dt * 16 + fq * 4;
    uint2 g = *(const uint2*)(zg + dd);
    float4 gs = *(const float4*)(gsub + dd);
    float o0 = O[0][dt][0] * rinv * gs.x * silu(bflo(g.x));
    float o1 = O[0][dt][1] * rinv * gs.y * silu(bfhi(g.x));
    float o2 = O[0][dt][2] * rinv * gs.z * silu(bflo(g.y));
    float o3 = O[0][dt][3] * rinv * gs.w * silu(bfhi(g.y));
    uint2 pk;
    pk.x = pack2(o0, o1);
    pk.y = pack2(o2, o3);
    *(uint2*)(yc + dd) = pk;
  }
}

DEV void hyena_item(const Params& p, int l, int grp, int idx) {
  const int tid = otid(), lane = tid & 63, wid = tid >> 6, fr = lane & 15, fq = lane >> 4;
  const int c = idx * 4 + wid;
  const int L = grp ? 2048 : 256, NB = L >> 4;
  const int gbase = grp ? 4096 : 0;
  const int CLdw = L + 16;
  const unsigned* P0 = (const unsigned*)(p.ws + OFF_G) + (size_t)l * GR_LAYER_DW + (grp ? GR_CTX_DW : 0) +
                       (size_t)(c * 2) * CLdw;
  const unsigned* P1 = P0 + CLdw;
  const bf16_t* UT = (const bf16_t*)(p.ws + OFF_H) + (size_t)c * MTOK + gbase + (fq & 1) * 8;
  f32x4 acc[16];
#pragma unroll
  for (int nb = 0; nb < 16; ++nb) acc[nb] = f32x4{0.f, 0.f, 0.f, 0.f};
  const int I0l = grp ? 0 : 0;
  (void)I0l;
  for (int D0 = -NB; D0 < NB; D0 += 2) {
    const int Dp = D0 + (fq >> 1);
    const int q0 = L - 16 * Dp - fr + 8 * (fq & 1);
    const unsigned* ap = (q0 & 1) ? (P1 + ((q0 - 1) >> 1)) : (P0 + (q0 >> 1));
    uint4 au;
    au.x = ap[0]; au.y = ap[1]; au.z = ap[2]; au.w = ap[3];
    uint4 bu[16];
#pragma unroll
    for (int nb = 0; nb < 16; ++nb) {
      const int I0 = grp ? (nb & 7) * 16 : 0;
      const int J = I0 + fr - Dp;
      const bool valid = (unsigned)J < (unsigned)NB;
      const int off = nb * 256 + (valid ? (fr - Dp) * 16 : 0);
      uint4 t = *(const uint4*)(UT + off);
      bu[nb] = valid ? t : uint4{0u, 0u, 0u, 0u};
    }
    const bf16x8 af = __builtin_bit_cast(bf16x8, au);
#pragma unroll
    for (int nb = 0; nb < 16; ++nb)
      acc[nb] = __builtin_amdgcn_mfma_f32_16x16x32_bf16(af, __builtin_bit_cast(bf16x8, bu[nb]), acc[nb], 0, 0, 0);
  }
  float* YT = (float*)(p.ws + OFF_UU) + (size_t)c * MTOK + gbase + 16 * fr + 4 * fq;
#pragma unroll
  for (int nb = 0; nb < 16; ++nb) *(f32x4*)(YT + nb * 256) = acc[nb];
}

DEV void hyena_epi(const Params& p, int idx, float* tile) {
  const int tid = otid();
  const int m0 = (idx & 127) * 64, c0 = (idx >> 7) * 64;
  const float* YT = (const float*)(p.ws + OFF_UU);
  {
    int c = tid >> 2, mq = (tid & 3) * 16;
    const float* src = YT + (size_t)(c0 + c) * MTOK + m0 + mq;
#pragma unroll
    for (int e = 0; e < 4; ++e) {
      float4 v = *(const float4*)(src + e * 4);
      float* d = tile + c * 65 + mq + e * 4;
      d[0] = v.x; d[1] = v.y; d[2] = v.z; d[3] = v.w;
    }
  }
  __syncthreads();
  {
    int m = tid >> 2, cq = (tid & 3) * 16;
    size_t mm = (size_t)(m0 + m);
    const float* x1 = (const float*)(p.ws + OFF_X1) + mm * 512 + c0 + cq;
    const bf16_t* zg = (const bf16_t*)(p.ws + OFF_Z) + mm * NIN + C_HYG + c0 + cq;
    bf16_t* ya = (bf16_t*)(p.ws + OFF_YA) + mm * 512 + c0 + cq;
    unsigned ow[8];
#pragma unroll
    for (int e = 0; e < 8; ++e) {
      v2f xv = *(const v2f*)(x1 + e * 2);
      unsigned g = *(const unsigned*)(zg + e * 2);
      float y0 = tile[(cq + e * 2) * 65 + m], y1 = tile[(cq + e * 2 + 1) * 65 + m];
      ow[e] = pack2(xv.x * y0 * silu(bflo(g)), xv.y * y1 * silu(bfhi(g)));
    }
    *(uint4*)(ya) = uint4{ow[0], ow[1], ow[2], ow[3]};
    *(uint4*)(ya + 8) = uint4{ow[4], ow[5], ow[6], ow[7]};
  }
  __syncthreads();
}

DEV void rwkv_fin(const Params& p, int l, int idx) {
  const int tid = otid();
  const int kq = tid & 15;
  const size_t DSTR = (size_t)MTOK * 512;
  const float* Y = (const float*)(p.ws + OFF_Y);
  const float* KD = (const float*)(p.ws + OFF_KD);
  float4 y0[2], y1[2], k0[2], k1[2], r[2], v[2], lw[2], lb[2], rk[2];
  uint2 g[2];
  size_t o[2];
#pragma unroll
  for (int u = 0; u < 2; ++u) {
    const int pr = idx * 32 + u * 16 + (tid >> 4);
    const int m = pr >> 3, h = pr & 7;
    const int c = h * 64 + kq * 4;
    o[u] = (size_t)m * 512 + c;
    y0[u] = *(const float4*)(Y + o[u]); y1[u] = *(const float4*)(Y + DSTR + o[u]);
    k0[u] = *(const float4*)(KD + o[u]); k1[u] = *(const float4*)(KD + DSTR + o[u]);
    r[u] = *(const float4*)((const float*)(p.ws + OFF_R) + o[u]);
    v[u] = *(const float4*)((const float*)(p.ws + OFF_V) + o[u]);
    g[u] = *(const uint2*)((const bf16_t*)(p.ws + OFF_Z) + (size_t)m * NIN + C_RWG + c);
    lw[u] = *(const float4*)(p.in[I_RLNW] + l * 512 + c);
    lb[u] = *(const float4*)(p.in[I_RLNB] + l * 512 + c);
    rk[u] = *(const float4*)(p.in[I_RRK] + l * 512 + c);
  }
#pragma unroll
  for (int u = 0; u < 2; ++u) {
    float4 y = float4{y0[u].x + y1[u].x, y0[u].y + y1[u].y, y0[u].z + y1[u].z, y0[u].w + y1[u].w};
    float mean = dpp_sum16(y.x + y.y + y.z + y.w) * (1.0f / 64.0f);
    float4 dv = float4{y.x - mean, y.y - mean, y.z - mean, y.w - mean};
    float var = dpp_sum16(dv.x * dv.x + dv.y * dv.y + dv.z * dv.z + dv.w * dv.w) * (1.0f / 64.0f);
    float rs = rsqrtf(var + 64e-5f);
    float bs = dpp_sum16(r[u].x * 0.5f * (k0[u].x + k1[u].x) * rk[u].x + r[u].y * 0.5f * (k0[u].y + k1[u].y) * rk[u].y +
                         r[u].z * 0.5f * (k0[u].z + k1[u].z) * rk[u].z + r[u].w * 0.5f * (k0[u].w + k1[u].w) * rk[u].w);
    float o0 = (dv.x * rs * lw[u].x + lb[u].x + bs * v[u].x) * silu(bflo(g[u].x));
    float o1 = (dv.y * rs * lw[u].y + lb[u].y + bs * v[u].y) * silu(bfhi(g[u].x));
    float o2 = (dv.z * rs * lw[u].z + lb[u].z + bs * v[u].z) * silu(bflo(g[u].y));
    float o3 = (dv.w * rs * lw[u].w + lb[u].w + bs * v[u].w) * silu(bfhi(g[u].y));
    uint2 pk;
    pk.x = pack2(o0, o1);
    pk.y = pack2(o2, o3);
    *(uint2*)((bf16_t*)(p.ws + OFF_YB) + o[u]) = pk;
  }
}

#define XB_TMO      128
#define XB_XCNT(j)  (256  + 64 * (j))
#define XB_XSUB(j)  (1280 + 64 * (j))
#define XB_XGEN(j)  (2304 + 64 * (j))
#define XB_TOP      3328
#define XB_TOPGEN   3392
#define XCD_BAR_WORDS 3456
#define XB_SPIN_CAP (1u << 18)
#define LAS __attribute__((address_space(3)))
DEV unsigned xb_ld(unsigned* p) { return __hip_atomic_load(p, __ATOMIC_RELAXED, __HIP_MEMORY_SCOPE_AGENT); }
DEV unsigned xb_add(unsigned* p, unsigned v) { return __hip_atomic_fetch_add(p, v, __ATOMIC_RELAXED, __HIP_MEMORY_SCOPE_AGENT); }
DEV unsigned xb_xcc_id() { return (unsigned)__builtin_amdgcn_s_getreg((3 << 11) | 20) & 0xFu; }
#define XB_SPIN(cond, bar) do { unsigned _sp = 0; while (cond) { __builtin_amdgcn_s_sleep(1); \
    if ((++_sp & 255u) == 0u) { if (xb_ld(&(bar)[XB_TMO])) break; if (_sp > XB_SPIN_CAP) { atomicAdd(&(bar)[XB_TMO], 1u); break; } } } } while (0)
struct XcdBarrier { unsigned* bar; unsigned x; volatile LAS unsigned* st; };
DEV XcdBarrier xcd_barrier_post(unsigned* bar, volatile LAS unsigned* st) {
  XcdBarrier b; b.bar = bar; b.x = xb_xcc_id(); b.st = st;
  if (threadIdx.x == 0) (void)xb_add(&bar[XB_XCNT(b.x)], 1u);
  return b;
}
DEV void xcd_barrier_complete(unsigned* bar, unsigned x, unsigned& nloc, unsigned& nx) {
  const unsigned G = gridDim.x * gridDim.y * gridDim.z;
  unsigned sum, cnt, mine, sp = 0u;
  for (;;) {
    sum = 0u; cnt = 0u; mine = 0u;
#pragma unroll
    for (unsigned j = 0; j < 16; ++j) { const unsigned c = xb_ld(&bar[XB_XCNT(j)]); sum += c; cnt += (c > 0u) ? 1u : 0u; mine = (j == x) ? c : mine; }
    if (sum == G) break;
    __builtin_amdgcn_s_sleep(1);
    if ((++sp & 255u) == 0u) { if (xb_ld(&bar[XB_TMO])) break; if (sp > XB_SPIN_CAP) { atomicAdd(&bar[XB_TMO], 1u); break; } }
  }
  nloc = mine > 0u ? mine : 1u; nx = cnt > 0u ? cnt : 1u;
}
DEV void xcd_barrier(const XcdBarrier& b) {
  asm volatile("s_waitcnt vmcnt(0)" ::: "memory");
  __syncthreads();
  if (threadIdx.x == 0) {
    unsigned* bar = b.bar;
    __builtin_amdgcn_s_waitcnt(0);
    unsigned nloc = b.st[0], nx = b.st[1];
    if (nloc == 0u) { xcd_barrier_complete(bar, b.x, nloc, nx); b.st[0] = nloc; b.st[1] = nx; }
    const unsigned old = xb_add(&bar[XB_XSUB(b.x)], 1u);
    const unsigned gen = old / nloc;
    if (old + 1u == (gen + 1u) * nloc) {
      __builtin_amdgcn_fence(__ATOMIC_RELEASE, "agent");
      asm volatile("s_waitcnt vmcnt(0)" ::: "memory");
      const unsigned og = xb_add(&bar[XB_TOP], 1u);
      const unsigned tg = og / nx;
      if (og + 1u == (tg + 1u) * nx) xb_add(&bar[XB_TOPGEN], 1u);
      else XB_SPIN(xb_ld(&bar[XB_TOPGEN]) == tg, bar);
      __builtin_amdgcn_fence(__ATOMIC_ACQUIRE, "agent");
      xb_add(&bar[XB_XGEN(b.x)], 1u);
      asm volatile("s_waitcnt vmcnt(0)" ::: "memory");
    } else {
      XB_SPIN(xb_ld(&bar[XB_XGEN(b.x)]) == gen, bar);
      __builtin_amdgcn_fence(__ATOMIC_ACQUIRE, "agent");
      asm volatile("s_waitcnt vmcnt(0)" ::: "memory");
    }
  }
  __syncthreads();
}

DEV void run_phase(const Params& p, int ph, char* smem, int* s_item_p) {
  const int nb = gridDim.x, bid = blockIdx.x;
  unsigned* counters = (unsigned*)(p.ws + OFF_CNT);
  if (ph == 0) {
    if (bid == 0 && threadIdx.x < 8) counters[threadIdx.x] = 0u;
    for (int it = bid; it < 4353; it += nb) {
      asm volatile("" ::: "memory");
      if (it < 192) p0_mod(p, it, (float*)smem);
      else if (it == 192) p0_misc(p);
      else if (it < 193 + 1152) p0_filter(p, it - 193, (float*)smem);
      else p0_transpose(p, it - 1345, (float*)smem);
    }
    return;
  }
  const int l = (ph - 1) / 7, st = (ph - 1) % 7;
  if (st == 0) {
    for (int it = bid; it < 1024; it += nb) { asm volatile("" ::: "memory"); norm_item(p, l, it); }
  } else if (st == 1) {
    for (int it = bid; it < 4736; it += nb) { asm volatile("" ::: "memory"); gemm_in_tile(p, l, it, (bf16_t*)smem); }
  } else if (st == 2) {
    for (int it = bid; it < 2608; it += nb) {
      asm volatile("" ::: "memory");
      if (it < 1024) prep_rwkv(p, l, it, (float*)smem);
      else if (it < 1536) prep_hyena(p, l, it - 1024);
      else if (it < 2048) prep_qk(p, l, it - 1536);
      else if (it < 2064) prep_kcache(p, l, it - 2048);
      else prep_vt(p, l, it - 2064, (bf16_t*)smem);
    }
  } else if (st == 3) {
    while (true) {
      __syncthreads();
      if (threadIdx.x == 0) *s_item_p = (int)atomicAdd(&counters[l], 1u);
      __syncthreads();
      int it = *s_item_p;
      asm volatile("" ::: "memory");
      if (it >= 1920) break;
      if (it < 128) {
        int b = it >> 6, r = it & 63;
        scan_item(p, l, 4096 + b * 2048, 2048, b, false, r >> 3, (r >> 2) & 1, r & 3, (float*)smem);
      } else if (it < 1152) {
        int i2 = it - 128;
        int b = i2 >> 6, r = i2 & 63;
        scan_item(p, l, b * 256, 256, b, true, r >> 3, (r >> 2) & 1, r & 3, (float*)smem);
      } else if (it < 1408) {
        int i2 = it - 1152;
        int b = i2 >> 7, h = (i2 >> 5) & 3, qt = i2 & 31;
        const bf16_t* vt = (const bf16_t*)(p.ws + OFF_VT) + (size_t)4096 * 512 + (size_t)(b * 4 + h) * 128 * 2304;
        attn_item(p, l, 4096 + b * 2048, qt, h, (size_t)4096 + (size_t)b * 2304, 2304, vt, (bf16_t*)smem);
      } else if (it < 1536) {
        hyena_item(p, l, 1, it - 1408);
      } else if (it < 1792) {
        int i2 = it - 1536;
        int b = i2 >> 4, h = (i2 >> 2) & 3, qt = i2 & 3;
        const bf16_t* vt = (const bf16_t*)(p.ws + OFF_VT) + (size_t)(b * 4 + h) * 128 * 256;
        attn_item(p, l, b * 256, qt, h, (size_t)b * 256, 256, vt, (bf16_t*)smem);
      } else {
        hyena_item(p, l, 0, it - 1792);
      }
    }
  } else if (st == 4) {
    for (int it = bid; it < 3072; it += nb) {
      asm volatile("" ::: "memory");
      if (it < 2048) rwkv_fin(p, l, it); else hyena_epi(p, it - 2048, (float*)smem);
    }
  } else if (st == 5) {
    for (int it = bid; it < 1024; it += nb) { asm volatile("" ::: "memory"); gemm_br_tile(p, l, it, (bf16_t*)smem); }
  } else {
    for (int it = bid; it < 512; it += nb) { asm volatile("" ::: "memory"); gemm_out_tile(p, l, it, (bf16_t*)smem); }
  }
}

#ifndef MULTI_LAUNCH
#define MULTI_LAUNCH 0
#endif

__global__ void __launch_bounds__(NT, 2) fwd_megakernel(Params p, int ph0, int ph1) {
  __shared__ __attribute__((aligned(16))) char smem[SMEM_BYTES];
  __shared__ int s_item;
  __shared__ uint4 xb_words;
#if !MULTI_LAUNCH
  cg::grid_group grid = cg::this_grid();
  if (ph0 < 0) grid.sync();
  if (threadIdx.x == 0) xb_words = make_uint4(0u, 0u, 0u, 0u);
  __syncthreads();
  XcdBarrier xb = xcd_barrier_post((unsigned*)(p.ws + OFF_BAR), (volatile LAS unsigned*)&xb_words);
#endif
  for (int ph = ph0; ph < ph1; ++ph) {
#if !MULTI_LAUNCH
    if (ph > ph0) xcd_barrier(xb);
#endif
    run_phase(p, ph, smem, &s_item);
  }
}

extern "C" void kernel_launch(void* const* d_in, const int* in_sizes, int n_in, void* d_out, int out_size, void* d_ws,
                              size_t ws_size, hipStream_t stream) {
  if (n_in < 39 || ws_size < WS_NEED) {
    fprintf(stderr, "kernel_launch: bad inputs n_in=%d ws=%zu need=%zu\n", n_in, ws_size, (size_t)WS_NEED);
    return;
  }
  static int grid_blocks = 0;
  if (!grid_blocks) {
    int dev = 0, cus = 0, per_cu = 0;
    (void)hipGetDevice(&dev);
    (void)hipDeviceGetAttribute(&cus, hipDeviceAttributeMultiprocessorCount, dev);
    (void)hipOccupancyMaxActiveBlocksPerMultiprocessor(&per_cu, fwd_megakernel, NT, 0);
    if (per_cu < 1) per_cu = 1;
    if (per_cu > 2) per_cu = 2;
    grid_blocks = cus * per_cu;
  }
  Params p{};
  for (int i = 0; i < 39; ++i) p.in[i] = (const float*)d_in[i];
  p.out = (float*)d_out;
  p.ws = (char*)d_ws;
#if !MULTI_LAUNCH
  (void)hipMemsetAsync((char*)d_ws + OFF_BAR, 0, XCD_BAR_WORDS_C * 4, stream);
#endif
#if MULTI_LAUNCH
  for (int ph = 0; ph < 29; ++ph) fwd_megakernel<<<dim3(grid_blocks), dim3(NT), 0, stream>>>(p, ph, ph + 1);
#else
  int ph0 = 0, ph1 = 29;
  void* args[] = {&p, &ph0, &ph1};
  hipError_t e = hipLaunchCooperativeKernel((void*)fwd_megakernel, dim3(grid_blocks), dim3(NT), args, 0, stream);
  if (e != hipSuccess) fprintf(stderr, "cooperative launch failed: %s (grid %d)\n", hipGetErrorString(e), grid_blocks);
#endif
}
```

```cpp
#include <hip/hip_runtime.h>
#include <hip/hip_bf16.h>
#include <hip/hip_cooperative_groups.h>
#include <cstdio>
namespace cg = cooperative_groups;

#define DEV __device__ __forceinline__
typedef unsigned short bf16_t;
using bf16x8 = __attribute__((ext_vector_type(8))) short;
using f32x4 = __attribute__((ext_vector_type(4))) float;
using v2f = __attribute__((ext_vector_type(2))) float;

constexpr int NT = 256;
constexpr int MTOK = 8192;
constexpr int NIN = 9472;
constexpr int C_HYZ = 0, C_HYG = 1536, C_RWZ = 2048, C_RWG = 3840, C_DAQ = 4352, C_DAK = 4864, C_DAV = 5376,
              C_DAG = 5888, C_MG = 6400;
constexpr int SMEM_BYTES = 43008;
constexpr int XCD_BAR_WORDS_C = 3456;

constexpr size_t O_YP = 0, O_YS = 4194304, O_CK = 8388608, O_CV = 16777216, O_ST = 25165824;

constexpr size_t SZ_TOK512F = (size_t)MTOK * 512 * 4;
constexpr size_t OFF_WTIN = 0;
constexpr size_t OFF_WTBR = OFF_WTIN + (size_t)4 * 9472 * 1024 * 2;
constexpr size_t OFF_WTOUT = OFF_WTBR + (size_t)4 * 3 * 1024 * 512 * 2;
constexpr size_t OFF_MOD = OFF_WTOUT + (size_t)4 * 1024 * 1024 * 2;
constexpr size_t OFF_G = OFF_MOD + (size_t)4 * 3 * 3072 * 4;
constexpr size_t GR_CTX_DW = (size_t)512 * 2 * 272;
constexpr size_t GR_SMP_DW = (size_t)512 * 2 * 2064;
constexpr size_t GR_LAYER_DW = GR_CTX_DW + GR_SMP_DW;
constexpr size_t OFF_ROPE = OFF_G + 4 * GR_LAYER_DW * 4;
constexpr size_t OFF_LAM = OFF_ROPE + 8192;
constexpr size_t OFF_H = OFF_LAM + 256;
constexpr size_t OFF_Z = OFF_H + (size_t)MTOK * 1024 * 2;
constexpr size_t OFF_UU = OFF_Z + (size_t)MTOK * NIN * 2;
constexpr size_t OFF_X1 = OFF_UU + SZ_TOK512F;
constexpr size_t OFF_R = OFF_X1 + SZ_TOK512F;
constexpr size_t OFF_KK = OFF_R + SZ_TOK512F;
constexpr size_t OFF_V = OFF_KK + SZ_TOK512F;
constexpr size_t OFF_W = OFF_V + SZ_TOK512F;
constexpr size_t OFF_BV = OFF_W + 2 * SZ_TOK512F;
constexpr size_t OFF_KD = OFF_BV + 2 * SZ_TOK512F;
constexpr size_t OFF_Y = OFF_KD + 2 * SZ_TOK512F;
constexpr size_t OFF_Q = OFF_Y + 2 * SZ_TOK512F;
constexpr size_t OFF_K = OFF_Q + (size_t)MTOK * 512 * 2;
constexpr size_t KROWS = 4096 + 2 * 2304;
constexpr size_t OFF_VT = OFF_K + KROWS * 512 * 2;
constexpr size_t OFF_YA = OFF_VT + KROWS * 512 * 2;
constexpr size_t OFF_YB = OFF_YA + (size_t)MTOK * 512 * 2;
constexpr size_t OFF_YC = OFF_YB + (size_t)MTOK * 512 * 2;
constexpr size_t OFF_CNT = OFF_YC + (size_t)MTOK * 512 * 2;
constexpr size_t OFF_BAR = OFF_CNT + 256;
constexpr size_t WS_NEED = OFF_BAR + XCD_BAR_WORDS_C * 4;

struct Params {
  const float* in[39];
  float* out;
  char* ws;
};

enum { I_XP = 0, I_XS, I_CK, I_CV, I_ST, I_C, I_CCTX, I_NORMG, I_WADA, I_BADA, I_WIN, I_HCW, I_HCB, I_HF1, I_HFB1,
       I_HFREQ, I_HF2, I_HFB2, I_HF3, I_HBIAS, I_RMU, I_RW0, I_RW2, I_RA0, I_RA2, I_RKK, I_RKA, I_RRK, I_RLNW,
       I_RLNB, I_GQ, I_GK, I_LQ1, I_LK1, I_LQ2, I_LK2, I_GSUB, I_WBR, I_WOUT };

DEV bf16_t f2bf(float f) {
  unsigned u = __float_as_uint(f);
  u += 0x7fffu + ((u >> 16) & 1u);
  return (bf16_t)(u >> 16);
}
DEV float bf2f(bf16_t h) { return __uint_as_float(((unsigned)h) << 16); }
typedef __bf16 bf16x2_t __attribute__((ext_vector_type(2)));
DEV unsigned pack2(float lo, float hi) {
  v2f v = v2f{lo, hi};
  bf16x2_t b = __builtin_convertvector(v, bf16x2_t);
  return __builtin_bit_cast(unsigned, b);
}
DEV float bflo(unsigned u) { return __uint_as_float(u << 16); }
DEV float bfhi(unsigned u) { return __uint_as_float(u & 0xffff0000u); }
DEV float sigm(float x) { return __builtin_amdgcn_rcpf(1.f + __expf(-x)); }
DEV float silu(float x) { return x * __builtin_amdgcn_rcpf(1.f + __expf(-x)); }
DEV float wave_sum(float v) {
#pragma unroll
  for (int o = 32; o > 0; o >>= 1) v += __shfl_xor(v, o);
  return v;
}
template <int CTRL> DEV float dppf(float x) {
  return __builtin_bit_cast(float, __builtin_amdgcn_mov_dpp(__builtin_bit_cast(int, x), CTRL, 0xf, 0xf, true));
}
DEV float dpp_sum16(float v) {
  v += dppf<0xB1>(v);
  v += dppf<0x4E>(v);
  v += dppf<0x141>(v);
  v += dppf<0x128>(v);
  return v;
}
DEV int otid() {
  int t = threadIdx.x;
  asm volatile("" : "+v"(t));
  return t;
}
DEV void tokinfo(int m, int& t, int& L) {
  if (m < 4096) { t = m & 255; L = 256; } else { t = (m - 4096) & 2047; L = 2048; }
}
DEV int condof(int m) { return m < 4096 ? 0 : 1 + ((m - 4096) >> 11); }

DEV void transpose_quad(const float* __restrict__ src, bf16_t* __restrict__ dst, int K, int N, int kt, int nq,
                        float* tile) {
  const int tid = otid();
  const int k0 = kt * 64, n0 = nq * 256;
  float v[4][16];
#pragma unroll
  for (int j = 0; j < 4; ++j)
#pragma unroll
    for (int i = 0; i < 16; ++i) {
      int k = i * 4 + (tid >> 6), n = tid & 63;
      v[j][i] = src[(size_t)(k0 + k) * N + n0 + j * 64 + n];
    }
#pragma unroll
  for (int j = 0; j < 4; ++j) {
#pragma unroll
    for (int i = 0; i < 16; ++i) {
      int k = i * 4 + (tid >> 6), n = tid & 63;
      tile[k * 65 + n] = v[j][i];
    }
    __syncthreads();
#pragma unroll
    for (int i = 0; i < 2; ++i) {
      int n = i * 32 + (tid >> 3), oc = (tid & 7) * 8;
      uint4 o;
      o.x = pack2(tile[(oc + 0) * 65 + n], tile[(oc + 1) * 65 + n]);
      o.y = pack2(tile[(oc + 2) * 65 + n], tile[(oc + 3) * 65 + n]);
      o.z = pack2(tile[(oc + 4) * 65 + n], tile[(oc + 5) * 65 + n]);
      o.w = pack2(tile[(oc + 6) * 65 + n], tile[(oc + 7) * 65 + n]);
      *(uint4*)(dst + (size_t)(n0 + j * 64 + n) * K + k0 + oc) = o;
    }
    __syncthreads();
  }
}

DEV void p0_transpose(const Params& p, int idx, float* sm) {
  int l = idx / 752, r = idx % 752;
  if (r < 592) {
    transpose_quad(p.in[I_WIN] + (size_t)l * 1024 * NIN, (bf16_t*)(p.ws + OFF_WTIN) + (size_t)l * NIN * 1024, 1024, NIN,
                   r / 37, r % 37, sm);
  } else if (r < 688) {
    int r2 = r - 592, i = r2 / 32, r3 = r2 % 32;
    transpose_quad(p.in[I_WBR] + (size_t)(l * 3 + i) * 512 * 1024,
                   (bf16_t*)(p.ws + OFF_WTBR) + (size_t)(l * 3 + i) * 1024 * 512, 512, 1024, r3 / 4, r3 % 4, sm);
  } else {
    int r2 = r - 688;
    transpose_quad(p.in[I_WOUT] + (size_t)l * 1024 * 1024, (bf16_t*)(p.ws + OFF_WTOUT) + (size_t)l * 1024 * 1024, 1024,
                   1024, r2 / 4, r2 % 4, sm);
  }
}

DEV void p0_mod(const Params& p, int idx, float* sm) {
  const int tid = otid();
  int l = idx / 48, jb = idx % 48;
  float* sc = sm;
  float* red = sm + 3072;
  for (int e = tid; e < 3072; e += NT) {
    int cond = e >> 10, i = e & 1023;
    float cv = cond == 0 ? p.in[I_CCTX][i] : p.in[I_C][(cond - 1) * 1024 + i];
    sc[e] = silu(cv);
  }
  __syncthreads();
  int jj = tid & 63, ig = tid >> 6;
  int j = jb * 64 + jj;
  const float* w = p.in[I_WADA] + (size_t)l * 1024 * 3072 + j;
  float a0 = 0.f, a1 = 0.f, a2 = 0.f;
#pragma unroll 8
  for (int i = ig * 256; i < ig * 256 + 256; ++i) {
    float wv = w[(size_t)i * 3072];
    a0 += wv * sc[i];
    a1 += wv * sc[1024 + i];
    a2 += wv * sc[2048 + i];
  }
  red[(0 * 4 + ig) * 64 + jj] = a0;
  red[(1 * 4 + ig) * 64 + jj] = a1;
  red[(2 * 4 + ig) * 64 + jj] = a2;
  __syncthreads();
  if (tid < 192) {
    int cond = tid >> 6, q = tid & 63;
    float s = red[(cond * 4 + 0) * 64 + q] + red[(cond * 4 + 1) * 64 + q] + red[(cond * 4 + 2) * 64 + q] +
              red[(cond * 4 + 3) * 64 + q];
    int jo = jb * 64 + q;
    s += p.in[I_BADA][l * 3072 + jo];
    ((float*)(p.ws + OFF_MOD))[(l * 3 + cond) * 3072 + jo] = s;
  }
  __syncthreads();
}

DEV void p0_misc(const Params& p) {
  const int tid = otid();
  float* rope = (float*)(p.ws + OFF_ROPE);
  for (int e = tid; e < 1024; e += NT) {
    int pos = e >> 4, jj = e & 15;
    float fr = powf(10000.0f, -(float)jj / 16.0f);
    float ang = (float)pos * fr;
    rope[e * 2] = cosf(ang);
    rope[e * 2 + 1] = sinf(ang);
  }
  if (tid < 4) {
    int l = tid;
    float s1 = 0.f, s2 = 0.f;
    for (int i = 0; i < 64; ++i) {
      s1 += p.in[I_LQ1][l * 64 + i] * p.in[I_LK1][l * 64 + i];
      s2 += p.in[I_LQ2][l * 64 + i] * p.in[I_LK2][l * 64 + i];
    }
    float li = 0.8f - 0.6f * expf(-0.3f * (float)l);
    float* lam = (float*)(p.ws + OFF_LAM);
    lam[l] = expf(s1) - expf(s2) + li;
    lam[4 + l] = li;
  }
}

DEV void p0_filter(const Params& p, int idx, float* sm) {
  const int tid = otid();
  int l = idx / 288, r = idx % 288;
  int L, d0, rowbase;
  if (r < 32) { L = 256; d0 = r * 8; rowbase = 0; } else { L = 2048; d0 = (r - 32) * 8; rowbase = 512; }
  float* zf = sm;
  float* h1 = sm + 272;
  float* h2 = h1 + 512;
  for (int e = tid; e < 264; e += NT) {
    int pp = e / 33, f = e % 33;
    int d = d0 + pp;
    float val;
    if (f == 0) {
      val = (float)d / (float)(L - 1);
    } else {
      float w = 6.283185307179586f * (float)d / (float)L;
      int bj = (f - 1) & 15;
      float band = 1e-4f + (float)bj * ((15.0f - 1e-4f) / 15.0f);
      float ang = band * w;
      val = (f <= 16) ? cosf(ang) : -sinf(ang);
    }
    zf[pp * 33 + f] = val;
  }
  __syncthreads();
  const float* f1 = p.in[I_HF1] + l * 33 * 64;
  const float* fb1 = p.in[I_HFB1] + l * 64;
  const float* fq = p.in[I_HFREQ] + l * 64;
  const float* f2 = p.in[I_HF2] + l * 64 * 64;
  const float* fb2 = p.in[I_HFB2] + l * 64;
  const float* f3 = p.in[I_HF3] + (size_t)l * 64 * 1024;
#pragma unroll
  for (int q = 0; q < 2; ++q) {
    int v = tid + 256 * q, pp = v >> 6, j = v & 63;
    float s = fb1[j];
#pragma unroll 11
    for (int f = 0; f < 33; ++f) s += zf[pp * 33 + f] * f1[f * 64 + j];
    h1[v] = sinf(fq[j] * s);
  }
  __syncthreads();
#pragma unroll
  for (int q = 0; q < 2; ++q) {
    int v = tid + 256 * q, pp = v >> 6, j = v & 63;
    float s = fb2[j];
#pragma unroll 16
    for (int i = 0; i < 64; ++i) s += h1[pp * 64 + i] * f2[i * 64 + j];
    h2[v] = sinf(fq[j] * s);
  }
  __syncthreads();
  bf16_t* GRb = (bf16_t*)((unsigned*)(p.ws + OFF_G) + (size_t)l * GR_LAYER_DW + (rowbase ? GR_CTX_DW : 0));
  const int CL = 2 * L + 32;
  const float dmin = 3.0701134573253944f, dmax = 15.350567286626972f;
  for (int q = 0; q < 4; ++q) {
    int o = tid + 256 * q;
    float acc[8];
#pragma unroll
    for (int pp = 0; pp < 8; ++pp) acc[pp] = 0.f;
#pragma unroll 8
    for (int j = 0; j < 64; ++j) {
      float wv = f3[j * 1024 + o];
#pragma unroll
      for (int pp = 0; pp < 8; ++pp) acc[pp] += h2[pp * 64 + j] * wv;
    }
    int c = o & 511;
    float delta = dmin + (float)c * ((dmax - dmin) / 511.0f);
    bf16_t* c0 = GRb + (size_t)(c * 2) * CL;
    bf16_t* c1 = c0 + CL;
#pragma unroll
    for (int pp = 0; pp < 8; ++pp) {
      int d = d0 + pp;
      float t = (float)d / (float)(L - 1);
      float val = acc[pp] * __expf(-t * delta);
      if (o < 512) {
        if (d == 0) val += p.in[I_HBIAS][l * 512 + c];
        int qq = L - d;
        bf16_t hv = f2bf(val);
        c0[qq] = hv;
        c1[qq - 1] = hv;
      } else if (d >= 1) {
        int qq = L + d;
        bf16_t hv = f2bf(val);
        c0[qq] = hv;
        c1[qq - 1] = hv;
      }
    }
    if (d0 == 0 && o < 512) {
      c0[0] = 0;
      for (int x = 2 * L; x < CL; ++x) c0[x] = 0;
      for (int x = 2 * L - 1; x < CL; ++x) c1[x] = 0;
    }
  }
  __syncthreads();
}

DEV void norm_item(const Params& p, int l, int idx) {
  const int tid = otid(), lane = tid & 63, wid = tid >> 6;
  float4 v[2][4];
  const float* g = p.in[I_NORMG] + l * 1024;
#pragma unroll
  for (int u = 0; u < 2; ++u) {
    int m = idx * 8 + u * 4 + wid;
    const float* x;
    if (l == 0) x = (m < 4096) ? p.in[I_XP] + (size_t)m * 1024 : p.in[I_XS] + (size_t)(m - 4096) * 1024;
    else x = p.out + (size_t)m * 1024;
#pragma unroll
    for (int i = 0; i < 4; ++i) v[u][i] = *(const float4*)(x + i * 256 + lane * 4);
  }
#pragma unroll
  for (int u = 0; u < 2; ++u) {
    int m = idx * 8 + u * 4 + wid;
    float ss = 0.f;
#pragma unroll
    for (int i = 0; i < 4; ++i)
      ss += v[u][i].x * v[u][i].x + v[u][i].y * v[u][i].y + v[u][i].z * v[u][i].z + v[u][i].w * v[u][i].w;
    ss = wave_sum(ss);
    float rinv = rsqrtf(ss * (1.0f / 1024.0f) + 1e-6f);
    const float* mod = (const float*)(p.ws + OFF_MOD) + (l * 3 + condof(m)) * 3072;
    bf16_t* h = (bf16_t*)(p.ws + OFF_H) + (size_t)m * 1024;
#pragma unroll
    for (int i = 0; i < 4; ++i) {
      int c = i * 256 + lane * 4;
      float4 gg = *(const float4*)(g + c);
      float4 sh = *(const float4*)(mod + c);
      float4 sc = *(const float4*)(mod + 1024 + c);
      float o0 = v[u][i].x * rinv * gg.x * (1.f + sc.x) + sh.x;
      float o1 = v[u][i].y * rinv * gg.y * (1.f + sc.y) + sh.y;
      float o2 = v[u][i].z * rinv * gg.z * (1.f + sc.z) + sh.z;
      float o3 = v[u][i].w * rinv * gg.w * (1.f + sc.w) + sh.w;
      uint2 pk;
      pk.x = pack2(o0, o1);
      pk.y = pack2(o2, o3);
      *(uint2*)(h + c) = pk;
    }
  }
}

template <int MTW>
DEV void gemm_kloop(const bf16_t* __restrict__ Wg, const bf16_t* __restrict__ Xg, int K, f32x4 (&acc)[4][MTW],
                    bf16_t* sm) {
  const int tid = otid(), lane = tid & 63, wid = tid >> 6, wn = wid >> 1, wm = wid & 1, fr = lane & 15,
            fq = lane >> 4;
  constexpr int XR = MTW / 2;
  bf16_t* sW = sm;
  bf16_t* sX = sm + 2 * 5120;
  uint4 rwA0, rwA1, rxA0, rxA1, rwB0, rwB1, rxB0, rxB1, rwC0, rwC1, rxC0, rxC1, rwD0, rwD1, rxD0, rxD1;
  rxA1 = rxB1 = rxC1 = rxD1 = uint4{0u, 0u, 0u, 0u};
  const int r0 = tid >> 2, kc = (tid & 3) * 8;
  const bf16_t* wp = Wg + (size_t)r0 * K + kc;
  const bf16_t* xp = Xg + (size_t)r0 * K + kc;
  const size_t step64 = (size_t)64 * K;
  const bf16_t* cWb = sW + (wn * 64 + fr) * 40 + fq * 8;
  const bf16_t* cXb = sX + (wm * (MTW * 16) + fr) * 40 + fq * 8;
#define GEMM_GL(S, kt_)                                                            \
  {                                                                                \
    const int ko_ = (kt_) * 32;                                                    \
    rw##S##0 = *(const uint4*)(wp + ko_);                                          \
    rw##S##1 = *(const uint4*)(wp + step64 + ko_);                                 \
    rx##S##0 = *(const uint4*)(xp + ko_);                                          \
    if constexpr (XR == 2) rx##S##1 = *(const uint4*)(xp + step64 + ko_);          \
  }
#define GEMM_SW(S, buf_)                                                           \
  {                                                                                \
    bf16_t* dW_ = sW + (buf_) * 5120;                                              \
    bf16_t* dX_ = sX + (buf_) * 5120;                                              \
    *(uint4*)(dW_ + r0 * 40 + kc) = rw##S##0;                                      \
    *(uint4*)(dW_ + (r0 + 64) * 40 + kc) = rw##S##1;                               \
    *(uint4*)(dX_ + r0 * 40 + kc) = rx##S##0;                                      \
    if constexpr (XR == 2) *(uint4*)(dX_ + (r0 + 64) * 40 + kc) = rx##S##1;        \
  }
  auto mma = [&](int buf) {
    const bf16_t* cW = cWb + buf * 5120;
    const bf16_t* cX = cXb + buf * 5120;
    bf16x8 a[4], bb[MTW];
#pragma unroll
    for (int i = 0; i < 4; ++i) a[i] = *(const bf16x8*)(cW + i * 16 * 40);
#pragma unroll
    for (int i = 0; i < MTW; ++i) bb[i] = *(const bf16x8*)(cX + i * 16 * 40);
#pragma unroll
    for (int nt = 0; nt < 4; ++nt)
#pragma unroll
      for (int mt = 0; mt < MTW; ++mt)
        acc[nt][mt] = __builtin_amdgcn_mfma_f32_16x16x32_bf16(a[nt], bb[mt], acc[nt][mt], 0, 0, 0);
  };
  const int nk = K >> 5;
  GEMM_GL(A, 0);
  GEMM_GL(B, 1);
  GEMM_GL(C, 2);
  GEMM_GL(D, 3);
  GEMM_SW(A, 0);
  __syncthreads();
  for (int kt = 0; kt < nk; kt += 4) {
    const bool more4 = (kt + 4 < nk);
    if (more4) GEMM_GL(A, kt + 4);
    mma(0);
    GEMM_SW(B, 1);
    __syncthreads();
    if (more4) GEMM_GL(B, kt + 5);
    mma(1);
    GEMM_SW(C, 0);
    __syncthreads();
    if (more4) GEMM_GL(C, kt + 6);
    mma(0);
    GEMM_SW(D, 1);
    __syncthreads();
    if (more4) GEMM_GL(D, kt + 7);
    mma(1);
    if (more4) GEMM_SW(A, 0);
    __syncthreads();
  }
#undef GEMM_GL
#undef GEMM_SW
}

DEV void gemm_in_tile(const Params& p, int l, int tile, bf16_t* sm) {
  const int tid = otid(), lane = tid & 63, wid = tid >> 6, wn = wid >> 1, wm = wid & 1, fr = lane & 15,
            fq = lane >> 4;
  int mt_ = tile & 63, nt_ = tile >> 6;
  int m0 = mt_ * 128, n0 = nt_ * 128;
  f32x4 acc[4][4];
#pragma unroll
  for (int a = 0; a < 4; ++a)
#pragma unroll
    for (int b = 0; b < 4; ++b) acc[a][b] = f32x4{0.f, 0.f, 0.f, 0.f};
  const bf16_t* Wt = (const bf16_t*)(p.ws + OFF_WTIN) + ((size_t)l * NIN + n0) * 1024;
  const bf16_t* X = (const bf16_t*)(p.ws + OFF_H) + (size_t)m0 * 1024;
  gemm_kloop<4>(Wt, X, 1024, acc, sm);
  bf16_t* z = (bf16_t*)(p.ws + OFF_Z);
#pragma unroll
  for (int nt = 0; nt < 4; ++nt)
#pragma unroll
    for (int mt = 0; mt < 4; ++mt) {
      int n = n0 + wn * 64 + nt * 16 + fq * 4;
      int m = m0 + wm * 64 + mt * 16 + fr;
      uint2 pk;
      pk.x = pack2(acc[nt][mt][0], acc[nt][mt][1]);
      pk.y = pack2(acc[nt][mt][2], acc[nt][mt][3]);
      *(uint2*)(z + (size_t)m * NIN + n) = pk;
    }
}

DEV void gemm_br_tile(const Params& p, int l, int tile, bf16_t* sm) {
  const int tid = otid(), lane = tid & 63, wid = tid >> 6, wn = wid >> 1, wm = wid & 1, fr = lane & 15,
            fq = lane >> 4;
  int mt_ = tile & 127, nt_ = tile >> 7;
  int m0 = mt_ * 64, n0 = nt_ * 128;
  f32x4 tot[4][2];
#pragma unroll
  for (int a = 0; a < 4; ++a)
#pragma unroll
    for (int b = 0; b < 2; ++b) tot[a][b] = f32x4{0.f, 0.f, 0.f, 0.f};
  const bf16_t* z = (const bf16_t*)(p.ws + OFF_Z);
#pragma unroll 1
  for (int br = 0; br < 3; ++br) {
    asm volatile("" ::: "memory");
    f32x4 acc[4][2];
#pragma unroll
    for (int a = 0; a < 4; ++a)
#pragma unroll
      for (int b = 0; b < 2; ++b) acc[a][b] = f32x4{0.f, 0.f, 0.f, 0.f};
    const bf16_t* Wt = (const bf16_t*)(p.ws + OFF_WTBR) + ((size_t)(l * 3 + br) * 1024 + n0) * 512;
    const bf16_t* X = (const bf16_t*)(p.ws + OFF_YA + (size_t)br * MTOK * 512 * 2) + (size_t)m0 * 512;
    gemm_kloop<2>(Wt, X, 512, acc, sm);
#pragma unroll
    for (int nt = 0; nt < 4; ++nt)
#pragma unroll
      for (int mt = 0; mt < 2; ++mt) {
        int n = n0 + wn * 64 + nt * 16 + fq * 4;
        int m = m0 + wm * 32 + mt * 16 + fr;
        uint2 g = *(const uint2*)(z + (size_t)m * NIN + C_MG + br * 1024 + n);
        tot[nt][mt][0] += sigm(bflo(g.x)) * acc[nt][mt][0];
        tot[nt][mt][1] += sigm(bfhi(g.x)) * acc[nt][mt][1];
        tot[nt][mt][2] += sigm(bflo(g.y)) * acc[nt][mt][2];
        tot[nt][mt][3] += sigm(bfhi(g.y)) * acc[nt][mt][3];
      }
  }
  bf16_t* mg = (bf16_t*)(p.ws + OFF_H);
#pragma unroll
  for (int nt = 0; nt < 4; ++nt)
#pragma unroll
    for (int mt = 0; mt < 2; ++mt) {
      int n = n0 + wn * 64 + nt * 16 + fq * 4;
      int m = m0 + wm * 32 + mt * 16 + fr;
      uint2 pk;
      pk.x = pack2(tot[nt][mt][0], tot[nt][mt][1]);
      pk.y = pack2(tot[nt][mt][2], tot[nt][mt][3]);
      *(uint2*)(mg + (size_t)m * 1024 + n) = pk;
    }
}

DEV void gemm_out_tile(const Params& p, int l, int tile, bf16_t* sm) {
  const int tid = otid(), lane = tid & 63, wid = tid >> 6, wn = wid >> 1, wm = wid & 1, fr = lane & 15,
            fq = lane >> 4;
  int mt_ = tile & 63, nt_ = tile >> 6;
  int m0 = mt_ * 128, n0 = nt_ * 128;
  f32x4 acc[4][4];
#pragma unroll
  for (int a = 0; a < 4; ++a)
#pragma unroll
    for (int b = 0; b < 4; ++b) acc[a][b] = f32x4{0.f, 0.f, 0.f, 0.f};
  const bf16_t* Wt = (const bf16_t*)(p.ws + OFF_WTOUT) + ((size_t)l * 1024 + n0) * 1024;
  const bf16_t* X = (const bf16_t*)(p.ws + OFF_H) + (size_t)m0 * 1024;
  gemm_kloop<4>(Wt, X, 1024, acc, sm);
  const float* gate = (const float*)(p.ws + OFF_MOD) + (l * 3 + condof(m0)) * 3072 + 2048;
#pragma unroll
  for (int nt = 0; nt < 4; ++nt)
#pragma unroll
    for (int mt = 0; mt < 4; ++mt) {
      int n = n0 + wn * 64 + nt * 16 + fq * 4;
      int m = m0 + wm * 64 + mt * 16 + fr;
      const float* xin;
      if (l == 0) xin = (m < 4096) ? p.in[I_XP] + (size_t)m * 1024 : p.in[I_XS] + (size_t)(m - 4096) * 1024;
      else xin = p.out + (size_t)m * 1024;
      float4 xv = *(const float4*)(xin + n);
      float4 gv = *(const float4*)(gate + n);
      float4 o;
      o.x = xv.x + gv.x * acc[nt][mt][0];
      o.y = xv.y + gv.y * acc[nt][mt][1];
      o.z = xv.z + gv.z * acc[nt][mt][2];
      o.w = xv.w + gv.w * acc[nt][mt][3];
      *(float4*)(p.out + (size_t)m * 1024 + n) = o;
    }
}

DEV void prep_hyena(const Params& p, int l, int idx) {
  const int tid = otid();
  const int c2 = tid * 2;
  const bf16_t* z = (const bf16_t*)(p.ws + OFF_Z);
  const float* cw = p.in[I_HCW] + l * 3 * 1536;
  const float* cb = p.in[I_HCB] + l * 1536;
  bf16_t* ut = (bf16_t*)(p.ws + OFF_H);
  float* x1b = (float*)(p.ws + OFF_X1);
  v2f w0[3], w1[3], w2[3], bb[3];
#pragma unroll
  for (int pt = 0; pt < 3; ++pt) {
    int col = pt * 512 + c2;
    w0[pt] = *(const v2f*)(cw + col);
    w1[pt] = *(const v2f*)(cw + 1536 + col);
    w2[pt] = *(const v2f*)(cw + 3072 + col);
    bb[pt] = *(const v2f*)(cb + col);
  }
  const int m0 = idx * 16;
  unsigned ua[8], ub[8];
  v2f x1r[16];
  float pa = 0.f, pb = 0.f;
#pragma unroll
  for (int i = 0; i < 16; ++i) {
    int m = m0 + i, t, L;
    tokinfo(m, t, L);
    v2f u[3];
#pragma unroll
    for (int pt = 0; pt < 3; ++pt) {
      int col = C_HYZ + pt * 512 + c2;
      unsigned z0 = *(const unsigned*)(z + (size_t)m * NIN + col);
      unsigned zm = (t > 0) ? *(const unsigned*)(z + (size_t)(m - 1) * NIN + col) : 0u;
      unsigned zp = (t < L - 1) ? *(const unsigned*)(z + (size_t)(m + 1) * NIN + col) : 0u;
      v2f a = v2f{bflo(zm), bfhi(zm)}, b = v2f{bflo(z0), bfhi(z0)}, c = v2f{bflo(zp), bfhi(zp)};
      u[pt] = a * w0[pt] + b * w1[pt] + c * w2[pt] + bb[pt];
    }
    v2f uu = u[2] * u[0];
    x1r[i] = u[1];
    if (i & 1) {
      ua[i >> 1] = pack2(pa, uu.x);
      ub[i >> 1] = pack2(pb, uu.y);
    } else {
      pa = uu.x;
      pb = uu.y;
    }
  }
#pragma unroll
  for (int i = 0; i < 16; ++i) *(v2f*)(x1b + (size_t)(m0 + i) * 512 + c2) = x1r[i];
  bf16_t* d0 = ut + (size_t)c2 * MTOK + m0;
  bf16_t* d1 = d0 + MTOK;
  *(uint4*)(d0) = uint4{ua[0], ua[1], ua[2], ua[3]};
  *(uint4*)(d0 + 8) = uint4{ua[4], ua[5], ua[6], ua[7]};
  *(uint4*)(d1) = uint4{ub[0], ub[1], ub[2], ub[3]};
  *(uint4*)(d1 + 8) = uint4{ub[4], ub[5], ub[6], ub[7]};
}

DEV float zr_mix(const bf16_t* z, const float* mu, int m, int t, int L, int cc) {
  int col = C_RWZ + cc;
  float z0 = bf2f(z[(size_t)m * NIN + col]);
  float zm = (t > 0) ? bf2f(z[(size_t)(m - 1) * NIN + col]) : 0.f;
  float zp = (t < L - 1) ? bf2f(z[(size_t)(m + 1) * NIN + col]) : 0.f;
  return z0 + mu[cc] * (0.5f * (zm + zp) - z0);
}

DEV void prep_rwkv(const Params& p, int l, int idx, float* sm) {
  const int tid = otid();
  const bf16_t* z = (const bf16_t*)(p.ws + OFF_Z);
  const float* mu = p.in[I_RMU] + l * 1792;
  const int m0 = idx * 8;
  float* lora = sm;
  {
    int tk = tid >> 5, cc0 = (tid & 31) * 8;
    int m = m0 + tk, t, L;
    tokinfo(m, t, L);
#pragma unroll
    for (int e = 0; e < 8; ++e) {
      int cc = cc0 + e;
      float val = zr_mix(z, mu, m, t, L, 1536 + cc);
      int type = cc >> 6, j = cc & 63;
      if (type < 2) val = 1.f - 2.f * __builtin_amdgcn_rcpf(1.f + __expf(2.f * val));
      lora[(j * 4 + type) * 8 + tk] = val;
    }
  }
  __syncthreads();
  float* R = (float*)(p.ws + OFF_R);
  float* KK = (float*)(p.ws + OFF_KK);
  float* V = (float*)(p.ws + OFF_V);
  float* W = (float*)(p.ws + OFF_W);
  float* BV = (float*)(p.ws + OFF_BV);
  float* KD = (float*)(p.ws + OFF_KD);
  const size_t DSTR = (size_t)MTOK * 512;
  float acc[2][4][8];
#pragma unroll
  for (int s = 0; s < 2; ++s)
#pragma unroll
    for (int ty = 0; ty < 4; ++ty)
#pragma unroll
      for (int tk = 0; tk < 8; ++tk) acc[s][ty][tk] = 0.f;
  {
    const float* w2 = p.in[I_RW2] + (size_t)l * 2 * 64 * 512 + tid;
    const float* a2 = p.in[I_RA2] + (size_t)l * 2 * 64 * 512 + tid;
#pragma unroll 4
    for (int j = 0; j < 64; ++j) {
      float wv[2][4];
#pragma unroll
      for (int s = 0; s < 2; ++s) {
        wv[s][0] = w2[j * 512 + 256 * s];
        wv[s][1] = w2[(64 + j) * 512 + 256 * s];
        wv[s][2] = a2[j * 512 + 256 * s];
        wv[s][3] = a2[(64 + j) * 512 + 256 * s];
      }
#pragma unroll
      for (int ty = 0; ty < 4; ++ty) {
        float4 l0 = *(const float4*)(lora + (j * 4 + ty) * 8);
        float4 l1 = *(const float4*)(lora + (j * 4 + ty) * 8 + 4);
#pragma unroll
        for (int s = 0; s < 2; ++s) {
          acc[s][ty][0] += l0.x * wv[s][ty];
          acc[s][ty][1] += l0.y * wv[s][ty];
          acc[s][ty][2] += l0.z * wv[s][ty];
          acc[s][ty][3] += l0.w * wv[s][ty];
          acc[s][ty][4] += l1.x * wv[s][ty];
          acc[s][ty][5] += l1.y * wv[s][ty];
          acc[s][ty][6] += l1.z * wv[s][ty];
          acc[s][ty][7] += l1.w * wv[s][ty];
        }
      }
    }
  }
#pragma unroll
  for (int s = 0; s < 2; ++s) {
    int c = tid + 256 * s;
    float rr[8], kr[8], vr[8];
#pragma unroll
    for (int tk = 0; tk < 8; ++tk) {
      int m = m0 + tk, t, L;
      tokinfo(m, t, L);
      rr[tk] = zr_mix(z, mu, m, t, L, c);
      kr[tk] = zr_mix(z, mu, m, t, L, 512 + c);
      vr[tk] = zr_mix(z, mu, m, t, L, 1024 + c);
    }
    float w00 = p.in[I_RW0][(l * 2 + 0) * 512 + c], w01 = p.in[I_RW0][(l * 2 + 1) * 512 + c];
    float a00 = p.in[I_RA0][(l * 2 + 0) * 512 + c], a01 = p.in[I_RA0][(l * 2 + 1) * 512 + c];
    float kkw = p.in[I_RKK][l * 512 + c], kaw = p.in[I_RKA][l * 512 + c];
#pragma unroll
    for (int tk = 0; tk < 8; ++tk) {
      int m = m0 + tk;
      float r = rr[tk], k = kr[tk], v = vr[tk];
      float kk = k * kkw;
      float ss = wave_sum(kk * kk);
      kk = kk * rsqrtf(ss + 1e-12f);
      float wd0 = __expf(-0.6065306597126334f * sigm(w00 + acc[s][0][tk]));
      float wd1 = __expf(-0.6065306597126334f * sigm(w01 + acc[s][1][tk]));
      float ad0 = sigm(a00 + acc[s][2][tk]);
      float ad1 = sigm(a01 + acc[s][3][tk]);
      size_t o = (size_t)m * 512 + c;
      R[o] = r;
      KK[o] = kk;
      V[o] = v;
      W[o] = wd0;
      W[DSTR + o] = wd1;
      BV[o] = kk * ad0;
      BV[DSTR + o] = kk * ad1;
      KD[o] = k * (1.f + (ad0 - 1.f) * kaw);
      KD[DSTR + o] = k * (1.f + (ad1 - 1.f) * kaw);
    }
  }
  __syncthreads();
}

DEV void prep_qk(const Params& p, int l, int idx) {
  const int tid = otid();
  int gid = idx * 256 + tid;
  int m = gid >> 4, chunk = gid & 15;
  const bool isk = chunk >= 8;
  const int ch8 = chunk & 7;
  const bf16_t* z = (const bf16_t*)(p.ws + OFF_Z) + (size_t)m * NIN + (isk ? C_DAK : C_DAQ) + ch8 * 64;
  float x[64];
  float ss = 0.f;
#pragma unroll
  for (int i = 0; i < 8; ++i) {
    uint4 u = *(const uint4*)(z + i * 8);
    x[i * 8 + 0] = bflo(u.x); x[i * 8 + 1] = bfhi(u.x);
    x[i * 8 + 2] = bflo(u.y); x[i * 8 + 3] = bfhi(u.y);
    x[i * 8 + 4] = bflo(u.z); x[i * 8 + 5] = bfhi(u.z);
    x[i * 8 + 6] = bflo(u.w); x[i * 8 + 7] = bfhi(u.w);
  }
#pragma unroll
  for (int i = 0; i < 64; ++i) ss += x[i] * x[i];
  float rinv = rsqrtf(ss * (1.0f / 64.0f) + 1e-6f);
  const float* g = (isk ? p.in[I_GK] : p.in[I_GQ]) + l * 64;
#pragma unroll
  for (int i = 0; i < 64; ++i) x[i] = x[i] * rinv * g[i];
  int t, L;
  tokinfo(m, t, L);
  if (m < 4096) {
    if (isk) {
      int b = m >> 8;
      float* ck = p.out + O_CK + ((size_t)(b * 4 + l) * 256 + t) * 512 + ch8 * 64;
#pragma unroll
      for (int i = 0; i < 16; ++i) *(float4*)(ck + i * 4) = float4{x[i * 4], x[i * 4 + 1], x[i * 4 + 2], x[i * 4 + 3]};
    }
  } else {
    const float* rope = (const float*)(p.ws + OFF_ROPE);
    int row = t >> 6, colp = t & 63;
#pragma unroll
    for (int jj = 0; jj < 16; ++jj) {
      float c1 = rope[(row * 16 + jj) * 2], s1 = rope[(row * 16 + jj) * 2 + 1];
      float a = x[jj], b = x[16 + jj];
      x[jj] = a * c1 - b * s1;
      x[16 + jj] = a * s1 + b * c1;
      float c2 = rope[(colp * 16 + jj) * 2], s2 = rope[(colp * 16 + jj) * 2 + 1];
      float a2 = x[32 + jj], b2 = x[48 + jj];
      x[32 + jj] = a2 * c2 - b2 * s2;
      x[48 + jj] = a2 * s2 + b2 * c2;
    }
  }
  bf16_t* dst;
  if (!isk) {
#pragma unroll
    for (int i = 0; i < 64; ++i) x[i] *= 0.125f;
    dst = (bf16_t*)(p.ws + OFF_Q) + (size_t)m * 512 + ch8 * 64;
  } else {
    size_t krow = (m < 4096) ? (size_t)m : (size_t)4096 + (size_t)((m - 4096) >> 11) * 2304 + 256 + t;
    dst = (bf16_t*)(p.ws + OFF_K) + krow * 512 + ch8 * 64;
  }
#pragma unroll
  for (int i = 0; i < 8; ++i) {
    uint4 u;
    u.x = pack2(x[i * 8 + 0], x[i * 8 + 1]);
    u.y = pack2(x[i * 8 + 2], x[i * 8 + 3]);
    u.z = pack2(x[i * 8 + 4], x[i * 8 + 5]);
    u.w = pack2(x[i * 8 + 6], x[i * 8 + 7]);
    *(uint4*)(dst + i * 8) = u;
  }
}

DEV void prep_kcache(const Params& p, int l, int idx) {
  const int tid = otid();
  int gid = idx * 256 + tid;
  int b = gid >> 11, pp = (gid >> 3) & 255, ch8 = gid & 7;
  const float* src = p.in[I_CK] + ((size_t)(b * 4 + l) * 256 + pp) * 512 + ch8 * 64;
  bf16_t* dst = (bf16_t*)(p.ws + OFF_K) + ((size_t)4096 + (size_t)b * 2304 + pp) * 512 + ch8 * 64;
#pragma unroll
  for (int i = 0; i < 8; ++i) {
    float4 a = *(const float4*)(src + i * 8), c = *(const float4*)(src + i * 8 + 4);
    uint4 u;
    u.x = pack2(a.x, a.y); u.y = pack2(a.z, a.w); u.z = pack2(c.x, c.y); u.w = pack2(c.z, c.w);
    *(uint4*)(dst + i * 8) = u;
  }
}

DEV void prep_vt(const Params& p, int l, int idx, bf16_t* sv) {
  const int tid = otid();
  int h, kt, Lk;
  bf16_t* vt;
  const int i = tid >> 2, dq = (tid & 3) * 32;
  bf16_t* srow = sv + i * 136 + dq;
  if (idx < 256) {
    int seq = idx >> 4;
    h = (idx >> 2) & 3; kt = idx & 3; Lk = 256;
    vt = (bf16_t*)(p.ws + OFF_VT) + (size_t)(seq * 4 + h) * 128 * 256;
    int t = kt * 64 + i;
    int m = seq * 256 + t;
    const bf16_t* src = (const bf16_t*)(p.ws + OFF_Z) + (size_t)m * NIN + C_DAV + h * 128 + dq;
    float* cv = p.out + O_CV + ((size_t)(seq * 4 + l) * 256 + t) * 512 + h * 128 + dq;
#pragma unroll
    for (int e = 0; e < 4; ++e) {
      uint4 u = *(const uint4*)(src + e * 8);
      *(uint4*)(srow + e * 8) = u;
      *(float4*)(cv + e * 8) = float4{bflo(u.x), bfhi(u.x), bflo(u.y), bfhi(u.y)};
      *(float4*)(cv + e * 8 + 4) = float4{bflo(u.z), bfhi(u.z), bflo(u.w), bfhi(u.w)};
    }
  } else {
    int r = idx - 256;
    int b = r / 144;
    h = (r / 36) & 3; kt = r % 36; Lk = 2304;
    vt = (bf16_t*)(p.ws + OFF_VT) + (size_t)4096 * 512 + (size_t)(b * 4 + h) * 128 * 2304;
    if (kt < 4) {
      const float* src = p.in[I_CV] + ((size_t)(b * 4 + l) * 256 + kt * 64 + i) * 512 + h * 128 + dq;
#pragma unroll
      for (int e = 0; e < 4; ++e) {
        float4 a = *(const float4*)(src + e * 8), c = *(const float4*)(src + e * 8 + 4);
        uint4 u;
        u.x = pack2(a.x, a.y); u.y = pack2(a.z, a.w); u.z = pack2(c.x, c.y); u.w = pack2(c.z, c.w);
        *(uint4*)(srow + e * 8) = u;
      }
    } else {
      int m = 4096 + b * 2048 + (kt - 4) * 64 + i;
      const bf16_t* src = (const bf16_t*)(p.ws + OFF_Z) + (size_t)m * NIN + C_DAV + h * 128 + dq;
#pragma unroll
      for (int e = 0; e < 4; ++e) *(uint4*)(srow + e * 8) = *(const uint4*)(src + e * 8);
    }
  }
  __syncthreads();
  {
    int d = tid >> 1, half = tid & 1;
    bf16_t* dst = vt + (size_t)d * Lk + kt * 64 + half * 32;
#pragma unroll
    for (int e = 0; e < 4; ++e) {
      unsigned w[4];
#pragma unroll
      for (int q = 0; q < 4; ++q) {
        int k0 = half * 32 + e * 8 + q * 2;
        w[q] = (unsigned)sv[k0 * 136 + d] | ((unsigned)sv[(k0 + 1) * 136 + d] << 16);
      }
      *(uint4*)(dst + e * 8) = uint4{w[0], w[1], w[2], w[3]};
    }
  }
  __syncthreads();
}

DEV void scan_item(const Params& p, int l, int seqbase, int L, int b, bool is_ctx, int h, int d, int rq, float* sb) {
  const int tid = otid();
  const int vl = tid >> 4, kq = tid & 15;
  const int v = rq * 16 + vl;
  const size_t DSTR = (size_t)MTOK * 512;
  const float* W = (const float*)(p.ws + OFF_W) + d * DSTR;
  const float* BV = (const float*)(p.ws + OFF_BV) + d * DSTR;
  const float* KD = (const float*)(p.ws + OFF_KD) + d * DSTR;
  const float* KK = (const float*)(p.ws + OFF_KK);
  const float* R = (const float*)(p.ws + OFF_R);
  const float* V = (const float*)(p.ws + OFF_V);
  float* Y = (float*)(p.ws + OFF_Y) + d * DSTR;
  float4 S = float4{0.f, 0.f, 0.f, 0.f};
  if (!is_ctx) S = *(const float4*)(p.in[I_ST] + ((((size_t)(b * 4 + l) * 2 + d) * 8 + h) * 64 + v) * 64 + kq * 4);
  const int nch = L >> 4;
  float4 g0, g1, g2, g3, g4;
  float gv;
  {
    int sidx = vl;
    int t = d ? (L - 1 - sidx) : sidx;
    size_t m = (size_t)(seqbase + t);
    size_t off = m * 512 + h * 64 + kq * 4;
    g0 = *(const float4*)(W + off); g1 = *(const float4*)(KK + off); g2 = *(const float4*)(BV + off);
    g3 = *(const float4*)(KD + off); g4 = *(const float4*)(R + off);
    gv = V[m * 512 + h * 64 + rq * 16 + kq];
    float* dst = sb + vl * 336;
    *(float4*)(dst + kq * 4) = g0; *(float4*)(dst + 64 + kq * 4) = g1; *(float4*)(dst + 128 + kq * 4) = g2;
    *(float4*)(dst + 192 + kq * 4) = g3; *(float4*)(dst + 256 + kq * 4) = g4;
    dst[320 + kq] = gv;
  }
  __syncthreads();
  for (int c = 0; c < nch; ++c) {
    const bool more = (c + 1 < nch);
    if (more) {
      int sidx = (c + 1) * 16 + vl;
      int t = d ? (L - 1 - sidx) : sidx;
      size_t m = (size_t)(seqbase + t);
      size_t off = m * 512 + h * 64 + kq * 4;
      g0 = *(const float4*)(W + off); g1 = *(const float4*)(KK + off); g2 = *(const float4*)(BV + off);
      g3 = *(const float4*)(KD + off); g4 = *(const float4*)(R + off);
      gv = V[m * 512 + h * 64 + rq * 16 + kq];
    }
    const float* cur = sb + (c & 1) * (16 * 336);
    float ykeep = 0.f;
    float4 nw = *(const float4*)(cur + kq * 4);
    float4 nkk = *(const float4*)(cur + 64 + kq * 4);
    float4 nbv = *(const float4*)(cur + 128 + kq * 4);
    float4 nkd = *(const float4*)(cur + 192 + kq * 4);
    float4 nr = *(const float4*)(cur + 256 + kq * 4);
    float nvv = cur[320 + vl];
#pragma unroll
    for (int i = 0; i < 16; ++i) {
      const float4 w = nw, kk = nkk, bv = nbv, kd = nkd, r = nr;
      const float vv = nvv;
      if (i + 1 < 16) {
        const float* row = cur + (i + 1) * 336;
        nw = *(const float4*)(row + kq * 4);
        nkk = *(const float4*)(row + 64 + kq * 4);
        nbv = *(const float4*)(row + 128 + kq * 4);
        nkd = *(const float4*)(row + 192 + kq * 4);
        nr = *(const float4*)(row + 256 + kq * 4);
        nvv = row[320 + vl];
      }
      __builtin_amdgcn_sched_barrier(0);
      v2f pd = v2f{S.x, S.y} * v2f{kk.x, kk.y};
      pd = v2f{S.z, S.w} * v2f{kk.z, kk.w} + pd;
      float dot = dpp_sum16(pd.x + pd.y);
      S.x = S.x * w.x + vv * kd.x - dot * bv.x;
      S.y = S.y * w.y + vv * kd.y - dot * bv.y;
      S.z = S.z * w.z + vv * kd.z - dot * bv.z;
      S.w = S.w * w.w + vv * kd.w - dot * bv.w;
      v2f py = v2f{S.x, S.y} * v2f{r.x, r.y};
      py = v2f{S.z, S.w} * v2f{r.z, r.w} + py;
      float y = dpp_sum16(py.x + py.y);
      ykeep = (kq == i) ? y : ykeep;
      __builtin_amdgcn_sched_barrier(0);
    }
    {
      int sidx = c * 16 + kq;
      int t = d ? (L - 1 - sidx) : sidx;
      Y[(size_t)(seqbase + t) * 512 + h * 64 + v] = ykeep;
    }
    if (more) {
      float* dst = sb + ((c + 1) & 1) * (16 * 336) + vl * 336;
      *(float4*)(dst + kq * 4) = g0; *(float4*)(dst + 64 + kq * 4) = g1; *(float4*)(dst + 128 + kq * 4) = g2;
      *(float4*)(dst + 192 + kq * 4) = g3; *(float4*)(dst + 256 + kq * 4) = g4;
      dst[320 + kq] = gv;
    }
    __syncthreads();
  }
  if (is_ctx) {
    *(float4*)(p.out + O_ST + ((((size_t)(b * 4 + l) * 2 + d) * 8 + h) * 64 + v) * 64 + kq * 4) = S;
  }
}

DEV void attn_item(const Params& p, int l, int seqbase, int qt, int h, size_t krow0, int Lk, const bf16_t* vt,
                   bf16_t* sm) {
  const int tid = otid(), lane = tid & 63, wid = tid >> 6, fr = lane & 15, fq = lane >> 4;
  bf16_t* sK = sm;
  bf16_t* sV = sm + 64 * 136;
  const bf16_t* Kg = (const bf16_t*)(p.ws + OFF_K) + krow0 * 512 + h * 128;
  const int q0 = seqbase + qt * 64 + wid * 16;
  const bf16_t* Qg = (const bf16_t*)(p.ws + OFF_Q) + (size_t)(q0 + fr) * 512 + h * 128;
  bf16x8 qf[2][2];
#pragma unroll
  for (int mp = 0; mp < 2; ++mp)
#pragma unroll
    for (int ch = 0; ch < 2; ++ch) qf[mp][ch] = *(const bf16x8*)(Qg + mp * 64 + ch * 32 + fq * 8);
  f32x4 O[2][8];
#pragma unroll
  for (int mp = 0; mp < 2; ++mp)
#pragma unroll
    for (int dt = 0; dt < 8; ++dt) O[mp][dt] = f32x4{0.f, 0.f, 0.f, 0.f};
  float ls0 = 0.f, ls1 = 0.f;
  const int nkt = Lk >> 6;
  const int a_kr = tid >> 4, a_kc = (tid & 15) * 8;
  const int a_vr = tid >> 3, a_vc = (tid & 7) * 8;
  const bf16_t* kgp = Kg + (size_t)a_kr * 512 + a_kc;
  const bf16_t* vgp = vt + (size_t)a_vr * Lk + a_vc;
  uint4 pk0, pk1, pk2, pk3, pv0, pv1, pv2, pv3;
  pk0 = *(const uint4*)(kgp);
  pk1 = *(const uint4*)(kgp + (size_t)16 * 512);
  pk2 = *(const uint4*)(kgp + (size_t)32 * 512);
  pk3 = *(const uint4*)(kgp + (size_t)48 * 512);
  pv0 = *(const uint4*)(vgp);
  pv1 = *(const uint4*)(vgp + (size_t)32 * Lk);
  pv2 = *(const uint4*)(vgp + (size_t)64 * Lk);
  pv3 = *(const uint4*)(vgp + (size_t)96 * Lk);
  for (int kt = 0; kt < nkt; ++kt) {
    {
      bf16_t* dk = sK + a_kr * 136 + a_kc;
      *(uint4*)(dk) = pk0;
      *(uint4*)(dk + 16 * 136) = pk1;
      *(uint4*)(dk + 32 * 136) = pk2;
      *(uint4*)(dk + 48 * 136) = pk3;
      bf16_t* dv = sV + a_vr * 72 + a_vc;
      *(uint4*)(dv) = pv0;
      *(uint4*)(dv + 32 * 72) = pv1;
      *(uint4*)(dv + 64 * 72) = pv2;
      *(uint4*)(dv + 96 * 72) = pv3;
    }
    __syncthreads();
    if (kt + 1 < nkt) {
      const bf16_t* kn = kgp + (size_t)(kt + 1) * 64 * 512;
      const bf16_t* vn = vgp + (kt + 1) * 64;
      pk0 = *(const uint4*)(kn);
      pk1 = *(const uint4*)(kn + (size_t)16 * 512);
      pk2 = *(const uint4*)(kn + (size_t)32 * 512);
      pk3 = *(const uint4*)(kn + (size_t)48 * 512);
      pv0 = *(const uint4*)(vn);
      pv1 = *(const uint4*)(vn + (size_t)32 * Lk);
      pv2 = *(const uint4*)(vn + (size_t)64 * Lk);
      pv3 = *(const uint4*)(vn + (size_t)96 * Lk);
    }
    f32x4 s[2][4];
#pragma unroll
    for (int k16 = 0; k16 < 4; ++k16)
#pragma unroll
      for (int mp = 0; mp < 2; ++mp) {
        f32x4 a = f32x4{0.f, 0.f, 0.f, 0.f};
#pragma unroll
        for (int ch = 0; ch < 2; ++ch) {
          bf16x8 kf = *(const bf16x8*)(sK + (k16 * 16 + fr) * 136 + mp * 64 + ch * 32 + fq * 8);
          a = __builtin_amdgcn_mfma_f32_16x16x32_bf16(kf, qf[mp][ch], a, 0, 0, 0);
        }
        s[mp][k16] = a;
      }
    bf16x8 pf[2][2];
#pragma unroll
    for (int mp = 0; mp < 2; ++mp) {
      float lsum = 0.f;
#pragma unroll
      for (int k16 = 0; k16 < 4; ++k16)
#pragma unroll
        for (int j = 0; j < 4; ++j) {
          float e = __expf(s[mp][k16][j]);
          s[mp][k16][j] = e;
          lsum += e;
        }
      if (mp == 0) ls0 += lsum; else ls1 += lsum;
#pragma unroll
      for (int g = 0; g < 2; ++g) {
        uint4 fu;
        fu.x = pack2(s[mp][2 * g][0], s[mp][2 * g][1]);
        fu.y = pack2(s[mp][2 * g][2], s[mp][2 * g][3]);
        fu.z = pack2(s[mp][2 * g + 1][0], s[mp][2 * g + 1][1]);
        fu.w = pack2(s[mp][2 * g + 1][2], s[mp][2 * g + 1][3]);
        pf[mp][g] = __builtin_bit_cast(bf16x8, fu);
      }
    }
#pragma unroll
    for (int dt = 0; dt < 8; ++dt)
#pragma unroll
      for (int g = 0; g < 2; ++g) {
        const bf16_t* vp = sV + (dt * 16 + fr) * 72 + g * 32 + fq * 4;
        uint2 lo = *(const uint2*)(vp);
        uint2 hi = *(const uint2*)(vp + 16);
        uint4 u = uint4{lo.x, lo.y, hi.x, hi.y};
        bf16x8 vf = __builtin_bit_cast(bf16x8, u);
        O[0][dt] = __builtin_amdgcn_mfma_f32_16x16x32_bf16(vf, pf[0][g], O[0][dt], 0, 0, 0);
        O[1][dt] = __builtin_amdgcn_mfma_f32_16x16x32_bf16(vf, pf[1][g], O[1][dt], 0, 0, 0);
      }
    __syncthreads();
  }
  ls0 += __shfl_xor(ls0, 16); ls0 += __shfl_xor(ls0, 32);
  ls1 += __shfl_xor(ls1, 16); ls1 += __shfl_xor(ls1, 32);
  const float* lamp = (const float*)(p.ws + OFF_LAM);
  const float lam = lamp[l], lam_init = lamp[4 + l];
  const float i0 = 1.f / ls0, i1 = lam / ls1;
  float ss = 0.f;
#pragma unroll
  for (int dt = 0; dt < 8; ++dt)
#pragma unroll
    for (int j = 0; j < 4; ++j) {
      float o = O[0][dt][j] * i0 - O[1][dt][j] * i1;
      O[0][dt][j] = o;
      ss += o * o;
    }
  ss += __shfl_xor(ss, 16); ss += __shfl_xor(ss, 32);
  const float rinv = rsqrtf(ss * (1.0f / 128.0f) + 1e-5f) * (1.f - lam_init);
  const int m = q0 + fr;
  const bf16_t* zg = (const bf16_t*)(p.ws + OFF_Z) + (size_t)m * NIN + C_DAG + h * 128;
  bf16_t* yc = (bf16_t*)(p.ws + OFF_YC) + (size_t)m * 512 + h * 128;
  const float* gsub = p.in[I_GSUB] + l * 128;
#pragma unroll
  for (int dt = 0; dt < 8; ++dt) {
    int dd = dt * 16 + fq * 4;
    uint2 g = *(const uint2*)(zg + dd);
    float4 gs = *(const float4*)(gsub + dd);
    float o0 = O[0][dt][0] * rinv * gs.x * silu(bflo(g.x));
    float o1 = O[0][dt][1] * rinv * gs.y * silu(bfhi(g.x));
    float o2 = O[0][dt][2] * rinv * gs.z * silu(bflo(g.y));
    float o3 = O[0][dt][3] * rinv * gs.w * silu(bfhi(g.y));
    uint2 pk;
    pk.x = pack2(o0, o1);
    pk.y = pack2(o2, o3);
    *(uint2*)(yc + dd) = pk;
  }
}

DEV void hyena_item(const Params& p, int l, int grp, int idx) {
  const int tid = otid(), lane = tid & 63, wid = tid >> 6, fr = lane & 15, fq = lane >> 4;
  const int c = idx * 4 + wid;
  const int L = grp ? 2048 : 256, NB = L >> 4;
  const int gbase = grp ? 4096 : 0;
  const int CLdw = L + 16;
  const unsigned* P0 = (const unsigned*)(p.ws + OFF_G) + (size_t)l * GR_LAYER_DW + (grp ? GR_CTX_DW : 0) +
                       (size_t)(c * 2) * CLdw;
  const unsigned* P1 = P0 + CLdw;
  const bf16_t* UT = (const bf16_t*)(p.ws + OFF_H) + (size_t)c * MTOK + gbase + (fq & 1) * 8;
  f32x4 acc[16];
#pragma unroll
  for (int nb = 0; nb < 16; ++nb) acc[nb] = f32x4{0.f, 0.f, 0.f, 0.f};
  const int I0l = grp ? 0 : 0;
  (void)I0l;
  const bf16_t* zpad = (const bf16_t*)(P0 + L);
  for (int D0 = -NB; D0 < NB; D0 += 2) {
    const int Dp = D0 + (fq >> 1);
    const int q0 = L - 16 * Dp - fr + 8 * (fq & 1);
    const unsigned* ap = (q0 & 1) ? (P1 + ((q0 - 1) >> 1)) : (P0 + (q0 >> 1));
    uint4 au;
    au.x = ap[0]; au.y = ap[1]; au.z = ap[2]; au.w = ap[3];
    uint4 bu[16];
#pragma unroll
    for (int nb = 0; nb < 16; ++nb) {
      const int I0 = grp ? (nb & 7) * 16 : 0;
      const int J = I0 + fr - Dp;
      const bool valid = (unsigned)J < (unsigned)NB;
      const bf16_t* bp = valid ? (UT + nb * 256 + (fr - Dp) * 16) : zpad;
      bu[nb] = *(const uint4*)bp;
    }
    const bf16x8 af = __builtin_bit_cast(bf16x8, au);
#pragma unroll
    for (int nb = 0; nb < 16; ++nb)
      acc[nb] = __builtin_amdgcn_mfma_f32_16x16x32_bf16(af, __builtin_bit_cast(bf16x8, bu[nb]), acc[nb], 0, 0, 0);
  }
  float* YT = (float*)(p.ws + OFF_UU) + (size_t)c * MTOK + gbase + 16 * fr + 4 * fq;
#pragma unroll
  for (int nb = 0; nb < 16; ++nb) *(f32x4*)(YT + nb * 256) = acc[nb];
}

DEV void hyena_epi(const Params& p, int idx, float* tile) {
  const int tid = otid();
  const int m0 = (idx & 127) * 64, c0 = (idx >> 7) * 64;
  const float* YT = (const float*)(p.ws + OFF_UU);
  {
    int c = tid >> 2, mq = (tid & 3) * 16;
    const float* src = YT + (size_t)(c0 + c) * MTOK + m0 + mq;
#pragma unroll
    for (int e = 0; e < 4; ++e) {
      float4 v = *(const float4*)(src + e * 4);
      float* d = tile + c * 65 + mq + e * 4;
      d[0] = v.x; d[1] = v.y; d[2] = v.z; d[3] = v.w;
    }
  }
  __syncthreads();
  {
    int m = tid >> 2, cq = (tid & 3) * 16;
    size_t mm = (size_t)(m0 + m);
    const float* x1 = (const float*)(p.ws + OFF_X1) + mm * 512 + c0 + cq;
    const bf16_t* zg = (const bf16_t*)(p.ws + OFF_Z) + mm * NIN + C_HYG + c0 + cq;
    bf16_t* ya = (bf16_t*)(p.ws + OFF_YA) + mm * 512 + c0 + cq;
    unsigned ow[8];
#pragma unroll
    for (int e = 0; e < 8; ++e) {
      v2f xv = *(const v2f*)(x1 + e * 2);
      unsigned g = *(const unsigned*)(zg + e * 2);
      float y0 = tile[(cq + e * 2) * 65 + m], y1 = tile[(cq + e * 2 + 1) * 65 + m];
      ow[e] = pack2(xv.x * y0 * silu(bflo(g)), xv.y * y1 * silu(bfhi(g)));
    }
    *(uint4*)(ya) = uint4{ow[0], ow[1], ow[2], ow[3]};
    *(uint4*)(ya + 8) = uint4{ow[4], ow[5], ow[6], ow[7]};
  }
  __syncthreads();
}

DEV void rwkv_fin(const Params& p, int l, int idx) {
  const int tid = otid();
  const int kq = tid & 15;
  const size_t DSTR = (size_t)MTOK * 512;
  const float* Y = (const float*)(p.ws + OFF_Y);
  const float* KD = (const float*)(p.ws + OFF_KD);
  float4 y0[2], y1[2], k0[2], k1[2], r[2], v[2], lw[2], lb[2], rk[2];
  uint2 g[2];
  size_t o[2];
#pragma unroll
  for (int u = 0; u < 2; ++u) {
    const int pr = idx * 32 + u * 16 + (tid >> 4);
    const int m = pr >> 3, h = pr & 7;
    const int c = h * 64 + kq * 4;
    o[u] = (size_t)m * 512 + c;
    y0[u] = *(const float4*)(Y + o[u]); y1[u] = *(const float4*)(Y + DSTR + o[u]);
    k0[u] = *(const float4*)(KD + o[u]); k1[u] = *(const float4*)(KD + DSTR + o[u]);
    r[u] = *(const float4*)((const float*)(p.ws + OFF_R) + o[u]);
    v[u] = *(const float4*)((const float*)(p.ws + OFF_V) + o[u]);
    g[u] = *(const uint2*)((const bf16_t*)(p.ws + OFF_Z) + (size_t)m * NIN + C_RWG + c);
    lw[u] = *(const float4*)(p.in[I_RLNW] + l * 512 + c);
    lb[u] = *(const float4*)(p.in[I_RLNB] + l * 512 + c);
    rk[u] = *(const float4*)(p.in[I_RRK] + l * 512 + c);
  }
#pragma unroll
  for (int u = 0; u < 2; ++u) {
    float4 y = float4{y0[u].x + y1[u].x, y0[u].y + y1[u].y, y0[u].z + y1[u].z, y0[u].w + y1[u].w};
    float mean = dpp_sum16(y.x + y.y + y.z + y.w) * (1.0f / 64.0f);
    float4 dv = float4{y.x - mean, y.y - mean, y.z - mean, y.w - mean};
    float var = dpp_sum16(dv.x * dv.x + dv.y * dv.y + dv.z * dv.z + dv.w * dv.w) * (1.0f / 64.0f);
    float rs = rsqrtf(var + 64e-5f);
    float bs = dpp_sum16(r[u].x * 0.5f * (k0[u].x + k1[u].x) * rk[u].x + r[u].y * 0.5f * (k0[u].y + k1[u].y) * rk[u].y +
                         r[u].z * 0.5f * (k0[u].z + k1[u].z) * rk[u].z + r[u].w * 0.5f * (k0[u].w + k1[u].w) * rk[u].w);
    float o0 = (dv.x * rs * lw[u].x + lb[u].x + bs * v[u].x) * silu(bflo(g[u].x));
    float o1 = (dv.y * rs * lw[u].y + lb[u].y + bs * v[u].y) * silu(bfhi(g[u].x));
    float o2 = (dv.z * rs * lw[u].z + lb[u].z + bs * v[u].z) * silu(bflo(g[u].y));
    float o3 = (dv.w * rs * lw[u].w + lb[u].w + bs * v[u].w) * silu(bfhi(g[u].y));
    uint2 pk;
    pk.x = pack2(o0, o1);
    pk.y = pack2(o2, o3);
    *(uint2*)((bf16_t*)(p.ws + OFF_YB) + o[u]) = pk;
  }
}

#define XB_TMO      128
#define XB_XCNT(j)  (256  + 64 * (j))
#define XB_XSUB(j)  (1280 + 64 * (j))
#define XB_XGEN(j)  (2304 + 64 * (j))
#define XB_TOP      3328
#define XB_TOPGEN   3392
#define XCD_BAR_WORDS 3456
#define XB_SPIN_CAP (1u << 18)
#define LAS __attribute__((address_space(3)))
DEV unsigned xb_ld(unsigned* p) { return __hip_atomic_load(p, __ATOMIC_RELAXED, __HIP_MEMORY_SCOPE_AGENT); }
DEV unsigned xb_add(unsigned* p, unsigned v) { return __hip_atomic_fetch_add(p, v, __ATOMIC_RELAXED, __HIP_MEMORY_SCOPE_AGENT); }
DEV unsigned xb_xcc_id() { return (unsigned)__builtin_amdgcn_s_getreg((3 << 11) | 20) & 0xFu; }
#define XB_SPIN(cond, bar) do { unsigned _sp = 0; while (cond) { __builtin_amdgcn_s_sleep(1); \
    if ((++_sp & 255u) == 0u) { if (xb_ld(&(bar)[XB_TMO])) break; if (_sp > XB_SPIN_CAP) { atomicAdd(&(bar)[XB_TMO], 1u); break; } } } } while (0)
struct XcdBarrier { unsigned* bar; unsigned x; volatile LAS unsigned* st; };
DEV XcdBarrier xcd_barrier_post(unsigned* bar, volatile LAS unsigned* st) {
  XcdBarrier b; b.bar = bar; b.x = xb_xcc_id(); b.st = st;
  if (threadIdx.x == 0) (void)xb_add(&bar[XB_XCNT(b.x)], 1u);
  return b;
}
DEV void xcd_barrier_complete(unsigned* bar, unsigned x, unsigned& nloc, unsigned& nx) {
  const unsigned G = gridDim.x * gridDim.y * gridDim.z;
  unsigned sum, cnt, mine, sp = 0u;
  for (;;) {
    sum = 0u; cnt = 0u; mine = 0u;
#pragma unroll
    for (unsigned j = 0; j < 16; ++j) { const unsigned c = xb_ld(&bar[XB_XCNT(j)]); sum += c; cnt += (c > 0u) ? 1u : 0u; mine = (j == x) ? c : mine; }
    if (sum == G) break;
    __builtin_amdgcn_s_sleep(1);
    if ((++sp & 255u) == 0u) { if (xb_ld(&bar[XB_TMO])) break; if (sp > XB_SPIN_CAP) { atomicAdd(&bar[XB_TMO], 1u); break; } }
  }
  nloc = mine > 0u ? mine : 1u; nx = cnt > 0u ? cnt : 1u;
}
DEV void xcd_barrier(const XcdBarrier& b) {
  asm volatile("s_waitcnt vmcnt(0)" ::: "memory");
  __syncthreads();
  if (threadIdx.x == 0) {
    unsigned* bar = b.bar;
    __builtin_amdgcn_s_waitcnt(0);
    unsigned nloc = b.st[0], nx = b.st[1];
    if (nloc == 0u) { xcd_barrier_complete(bar, b.x, nloc, nx); b.st[0] = nloc; b.st[1] = nx; }
    const unsigned old = xb_add(&bar[XB_XSUB(b.x)], 1u);
    const unsigned gen = old / nloc;
    if (old + 1u == (gen + 1u) * nloc) {
      __builtin_amdgcn_fence(__ATOMIC_RELEASE, "agent");
      asm volatile("s_waitcnt vmcnt(0)" ::: "memory");
      const unsigned og = xb_add(&bar[XB_TOP], 1u);
      const unsigned tg = og / nx;
      if (og + 1u == (tg + 1u) * nx) xb_add(&bar[XB_TOPGEN], 1u);
      else XB_SPIN(xb_ld(&bar[XB_TOPGEN]) == tg, bar);
      __builtin_amdgcn_fence(__ATOMIC_ACQUIRE, "agent");
      xb_add(&bar[XB_XGEN(b.x)], 1u);
      asm volatile("s_waitcnt vmcnt(0)" ::: "memory");
    } else {
      XB_SPIN(xb_ld(&bar[XB_XGEN(b.x)]) == gen, bar);
      __builtin_amdgcn_fence(__ATOMIC_ACQUIRE, "agent");
      asm volatile("s_waitcnt vmcnt(0)" ::: "memory");
    }
  }
  __syncthreads();
}

DEV void run_phase(const Params& p, int ph, char* smem, int* s_item_p) {
  const int nb = gridDim.x, bid = blockIdx.x;
  unsigned* counters = (unsigned*)(p.ws + OFF_CNT);
  if (ph == 0) {
    if (bid == 0 && threadIdx.x < 8) counters[threadIdx.x] = 0u;
    for (int it = bid; it < 4353; it += nb) {
      asm volatile("" ::: "memory");
      if (it < 192) p0_mod(p, it, (float*)smem);
      else if (it == 192) p0_misc(p);
      else if (it < 193 + 1152) p0_filter(p, it - 193, (float*)smem);
      else p0_transpose(p, it - 1345, (float*)smem);
    }
    return;
  }
  const int l = (ph - 1) / 7, st = (ph - 1) % 7;
  if (st == 0) {
    for (int it = bid; it < 1024; it += nb) { asm volatile("" ::: "memory"); norm_item(p, l, it); }
  } else if (st == 1) {
    for (int it = bid; it < 4736; it += nb) { asm volatile("" ::: "memory"); gemm_in_tile(p, l, it, (bf16_t*)smem); }
  } else if (st == 2) {
    for (int it = bid; it < 2608; it += nb) {
      asm volatile("" ::: "memory");
      if (it < 1024) prep_rwkv(p, l, it, (float*)smem);
      else if (it < 1536) prep_hyena(p, l, it - 1024);
      else if (it < 2048) prep_qk(p, l, it - 1536);
      else if (it < 2064) prep_kcache(p, l, it - 2048);
      else prep_vt(p, l, it - 2064, (bf16_t*)smem);
    }
  } else if (st == 3) {
    while (true) {
      __syncthreads();
      if (threadIdx.x == 0) *s_item_p = (int)atomicAdd(&counters[l], 1u);
      __syncthreads();
      int it = *s_item_p;
      asm volatile("" ::: "memory");
      if (it >= 1920) break;
      if (it < 128) {
        int b = it >> 6, r = it & 63;
        scan_item(p, l, 4096 + b * 2048, 2048, b, false, r >> 3, (r >> 2) & 1, r & 3, (float*)smem);
      } else if (it < 1152) {
        int i2 = it - 128;
        int b = i2 >> 6, r = i2 & 63;
        scan_item(p, l, b * 256, 256, b, true, r >> 3, (r >> 2) & 1, r & 3, (float*)smem);
      } else if (it < 1408) {
        int i2 = it - 1152;
        int b = i2 >> 7, h = (i2 >> 5) & 3, qt = i2 & 31;
        const bf16_t* vt = (const bf16_t*)(p.ws + OFF_VT) + (size_t)4096 * 512 + (size_t)(b * 4 + h) * 128 * 2304;
        attn_item(p, l, 4096 + b * 2048, qt, h, (size_t)4096 + (size_t)b * 2304, 2304, vt, (bf16_t*)smem);
      } else if (it < 1536) {
        hyena_item(p, l, 1, it - 1408);
      } else if (it < 1792) {
        int i2 = it - 1536;
        int b = i2 >> 4, h = (i2 >> 2) & 3, qt = i2 & 3;
        const bf16_t* vt = (const bf16_t*)(p.ws + OFF_VT) + (size_t)(b * 4 + h) * 128 * 256;
        attn_item(p, l, b * 256, qt, h, (size_t)b * 256, 256, vt, (bf16_t*)smem);
      } else {
        hyena_item(p, l, 0, it - 1792);
      }
    }
  } else if (st == 4) {
    for (int it = bid; it < 3072; it += nb) {
      asm volatile("" ::: "memory");
      if (it < 2048) rwkv_fin(p, l, it); else hyena_epi(p, it - 2048, (float*)smem);
    }
  } else if (st == 5) {
    for (int it = bid; it < 1024; it += nb) { asm volatile("" ::: "memory"); gemm_br_tile(p, l, it, (bf16_t*)smem); }
  } else {
    for (int it = bid; it < 512; it += nb) { asm volatile("" ::: "memory"); gemm_out_tile(p, l, it, (bf16_t*)smem); }
  }
}

#ifndef MULTI_LAUNCH
#define MULTI_LAUNCH 0
#endif

__global__ void __launch_bounds__(NT, 2) fwd_megakernel(Params p, int ph0, int ph1) {
  __shared__ __attribute__((aligned(16))) char smem[SMEM_BYTES];
  __shared__ int s_item;
  __shared__ uint4 xb_words;
#if !MULTI_LAUNCH
  cg::grid_group grid = cg::this_grid();
  if (ph0 < 0) grid.sync();
  if (threadIdx.x == 0) xb_words = make_uint4(0u, 0u, 0u, 0u);
  __syncthreads();
  XcdBarrier xb = xcd_barrier_post((unsigned*)(p.ws + OFF_BAR), (volatile LAS unsigned*)&xb_words);
#endif
  for (int ph = ph0; ph < ph1; ++ph) {
#if !MULTI_LAUNCH
    if (ph > ph0) xcd_barrier(xb);
#endif
    run_phase(p, ph, smem, &s_item);
  }
}

extern "C" void kernel_launch(void* const* d_in, const int* in_sizes, int n_in, void* d_out, int out_size, void* d_ws,
                              size_t ws_size, hipStream_t stream) {
  if (n_in < 39 || ws_size < WS_NEED) {
    fprintf(stderr, "kernel_launch: bad inputs n_in=%d ws=%zu need=%zu\n", n_in, ws_size, (size_t)WS_NEED);
    return;
  }
  static int grid_blocks = 0;
  if (!grid_blocks) {
    int dev = 0, cus = 0, per_cu = 0;
    (void)hipGetDevice(&dev);
    (void)hipDeviceGetAttribute(&cus, hipDeviceAttributeMultiprocessorCount, dev);
    (void)hipOccupancyMaxActiveBlocksPerMultiprocessor(&per_cu, fwd_megakernel, NT, 0);
    if (per_cu < 1) per_cu = 1;
    if (per_cu > 2) per_cu = 2;
    grid_blocks = cus * per_cu;
  }
  Params p{};
  for (int i = 0; i < 39; ++i) p.in[i] = (const float*)d_in[i];
  p.out = (float*)d_out;
  p.ws = (char*)d_ws;
#if !MULTI_LAUNCH
  (void)hipMemsetAsync((char*)d_ws + OFF_BAR, 0, XCD_BAR_WORDS_C * 4, stream);
#endif
#if MULTI_LAUNCH
  for (int ph = 0; ph < 29; ++ph) fwd_megakernel<<<dim3(grid_blocks), dim3(NT), 0, stream>>>(p, ph, ph + 1);
#else
  int ph0 = 0, ph1 = 29;
  void* args[] = {&p, &ph0, &ph1};
  hipError_t e = hipLaunchCooperativeKernel((void*)fwd_megakernel, dim3(grid_blocks), dim3(NT), args, 0, stream);
  if (e != hipSuccess) fprintf(stderr, "cooperative launch failed: %s (grid %d)\n", hipGetErrorString(e), grid_blocks);
#endif
}
```

```cpp
#include <hip/hip_runtime.h>
#include <hip/hip_bf16.h>
#include <hip/hip_cooperative_groups.h>
#include <cstdio>
namespace cg = cooperative_groups;

#define DEV __device__ __forceinline__
typedef unsigned short bf16_t;
using bf16x8 = __attribute__((ext_vector_type(8))) short;
using f32x4 = __attribute__((ext_vector_type(4))) float;
using v2f = __attribute__((ext_vector_type(2))) float;

constexpr int NT = 256;
constexpr int MTOK = 8192;
constexpr int NIN = 9472;
constexpr int C_HYZ = 0, C_HYG = 1536, C_RWZ = 2048, C_RWG = 3840, C_DAQ = 4352, C_DAK = 4864, C_DAV = 5376,
              C_DAG = 5888, C_MG = 6400;
constexpr int SMEM_BYTES = 43008;
constexpr int XCD_BAR_WORDS_C = 3456;

constexpr size_t O_YP = 0, O_YS = 4194304, O_CK = 8388608, O_CV = 16777216, O_ST = 25165824;

constexpr size_t SZ_TOK512F = (size_t)MTOK * 512 * 4;
constexpr size_t OFF_WTIN = 0;
constexpr size_t OFF_WTBR = OFF_WTIN + (size_t)4 * 9472 * 1024 * 2;
constexpr size_t OFF_WTOUT = OFF_WTBR + (size_t)4 * 3 * 1024 * 512 * 2;
constexpr size_t OFF_MOD = OFF_WTOUT + (size_t)4 * 1024 * 1024 * 2;
constexpr size_t OFF_G = OFF_MOD + (size_t)4 * 3 * 3072 * 4;
constexpr size_t GR_CTX_DW = (size_t)512 * 2 * 272;
constexpr size_t GR_SMP_DW = (size_t)512 * 2 * 2064;
constexpr size_t GR_LAYER_DW = GR_CTX_DW + GR_SMP_DW;
constexpr size_t OFF_ROPE = OFF_G + 4 * GR_LAYER_DW * 4;
constexpr size_t OFF_LAM = OFF_ROPE + 8192;
constexpr size_t OFF_H = OFF_LAM + 256;
constexpr size_t OFF_Z = OFF_H + (size_t)MTOK * 1024 * 2;
constexpr size_t OFF_UU = OFF_Z + (size_t)MTOK * NIN * 2;
constexpr size_t OFF_X1 = OFF_UU + SZ_TOK512F;
constexpr size_t OFF_R = OFF_X1 + SZ_TOK512F;
constexpr size_t OFF_KK = OFF_R + SZ_TOK512F;
constexpr size_t OFF_V = OFF_KK + SZ_TOK512F;
constexpr size_t OFF_W = OFF_V + SZ_TOK512F;
constexpr size_t OFF_BV = OFF_W + 2 * SZ_TOK512F;
constexpr size_t OFF_KD = OFF_BV + 2 * SZ_TOK512F;
constexpr size_t OFF_Y = OFF_KD + 2 * SZ_TOK512F;
constexpr size_t OFF_Q = OFF_Y + 2 * SZ_TOK512F;
constexpr size_t OFF_K = OFF_Q + (size_t)MTOK * 512 * 2;
constexpr size_t KROWS = 4096 + 2 * 2304;
constexpr size_t OFF_VT = OFF_K + KROWS * 512 * 2;
constexpr size_t OFF_YA = OFF_VT + KROWS * 512 * 2;
constexpr size_t OFF_YB = OFF_YA + (size_t)MTOK * 512 * 2;
constexpr size_t OFF_YC = OFF_YB + (size_t)MTOK * 512 * 2;
constexpr size_t OFF_CNT = OFF_YC + (size_t)MTOK * 512 * 2;
constexpr size_t OFF_BAR = OFF_CNT + 256;
constexpr size_t WS_NEED = OFF_BAR + XCD_BAR_WORDS_C * 4;

struct Params {
  const float* in[39];
  float* out;
  char* ws;
};

enum { I_XP = 0, I_XS, I_CK, I_CV, I_ST, I_C, I_CCTX, I_NORMG, I_WADA, I_BADA, I_WIN, I_HCW, I_HCB, I_HF1, I_HFB1,
       I_HFREQ, I_HF2, I_HFB2, I_HF3, I_HBIAS, I_RMU, I_RW0, I_RW2, I_RA0, I_RA2, I_RKK, I_RKA, I_RRK, I_RLNW,
       I_RLNB, I_GQ, I_GK, I_LQ1, I_LK1, I_LQ2, I_LK2, I_GSUB, I_WBR, I_WOUT };

DEV bf16_t f2bf(float f) {
  unsigned u = __float_as_uint(f);
  u += 0x7fffu + ((u >> 16) & 1u);
  return (bf16_t)(u >> 16);
}
DEV float bf2f(bf16_t h) { return __uint_as_float(((unsigned)h) << 16); }
typedef __bf16 bf16x2_t __attribute__((ext_vector_type(2)));
DEV unsigned pack2(float lo, float hi) {
  v2f v = v2f{lo, hi};
  bf16x2_t b = __builtin_convertvector(v, bf16x2_t);
  return __builtin_bit_cast(unsigned, b);
}
DEV float bflo(unsigned u) { return __uint_as_float(u << 16); }
DEV float bfhi(unsigned u) { return __uint_as_float(u & 0xffff0000u); }
DEV float sigm(float x) { return __builtin_amdgcn_rcpf(1.f + __expf(-x)); }
DEV float silu(float x) { return x * __builtin_amdgcn_rcpf(1.f + __expf(-x)); }
DEV float wave_sum(float v) {
#pragma unroll
  for (int o = 32; o > 0; o >>= 1) v += __shfl_xor(v, o);
  return v;
}
template <int CTRL> DEV float dppf(float x) {
  return __builtin_bit_cast(float, __builtin_amdgcn_mov_dpp(__builtin_bit_cast(int, x), CTRL, 0xf, 0xf, true));
}
DEV float dpp_sum16(float v) {
  v += dppf<0xB1>(v);
  v += dppf<0x4E>(v);
  v += dppf<0x141>(v);
  v += dppf<0x128>(v);
  return v;
}
DEV int otid() {
  int t = threadIdx.x;
  asm volatile("" : "+v"(t));
  return t;
}
DEV void tokinfo(int m, int& t, int& L) {
  if (m < 4096) { t = m & 255; L = 256; } else { t = (m - 4096) & 2047; L = 2048; }
}
DEV int condof(int m) { return m < 4096 ? 0 : 1 + ((m - 4096) >> 11); }

DEV void transpose_quad(const float* __restrict__ src, bf16_t* __restrict__ dst, int K, int N, int kt, int nq,
                        float* tile) {
  const int tid = otid();
  const int k0 = kt * 64, n0 = nq * 256;
  float v[4][16];
#pragma unroll
  for (int j = 0; j < 4; ++j)
#pragma unroll
    for (int i = 0; i < 16; ++i) {
      int k = i * 4 + (tid >> 6), n = tid & 63;
      v[j][i] = src[(size_t)(k0 + k) * N + n0 + j * 64 + n];
    }
#pragma unroll
  for (int j = 0; j < 4; ++j) {
#pragma unroll
    for (int i = 0; i < 16; ++i) {
      int k = i * 4 + (tid >> 6), n = tid & 63;
      tile[k * 65 + n] = v[j][i];
    }
    __syncthreads();
#pragma unroll
    for (int i = 0; i < 2; ++i) {
      int n = i * 32 + (tid >> 3), oc = (tid & 7) * 8;
      uint4 o;
      o.x = pack2(tile[(oc + 0) * 65 + n], tile[(oc + 1) * 65 + n]);
      o.y = pack2(tile[(oc + 2) * 65 + n], tile[(oc + 3) * 65 + n]);
      o.z = pack2(tile[(oc + 4) * 65 + n], tile[(oc + 5) * 65 + n]);
      o.w = pack2(tile[(oc + 6) * 65 + n], tile[(oc + 7) * 65 + n]);
      *(uint4*)(dst + (size_t)(n0 + j * 64 + n) * K + k0 + oc) = o;
    }
    __syncthreads();
  }
}

DEV void p0_transpose(const Params& p, int idx, float* sm) {
  int l = idx / 752, r = idx % 752;
  if (r < 592) {
    transpose_quad(p.in[I_WIN] + (size_t)l * 1024 * NIN, (bf16_t*)(p.ws + OFF_WTIN) + (size_t)l * NIN * 1024, 1024, NIN,
                   r / 37, r % 37, sm);
  } else if (r < 688) {
    int r2 = r - 592, i = r2 / 32, r3 = r2 % 32;
    transpose_quad(p.in[I_WBR] + (size_t)(l * 3 + i) * 512 * 1024,
                   (bf16_t*)(p.ws + OFF_WTBR) + (size_t)(l * 3 + i) * 1024 * 512, 512, 1024, r3 / 4, r3 % 4, sm);
  } else {
    int r2 = r - 688;
    transpose_quad(p.in[I_WOUT] + (size_t)l * 1024 * 1024, (bf16_t*)(p.ws + OFF_WTOUT) + (size_t)l * 1024 * 1024, 1024,
                   1024, r2 / 4, r2 % 4, sm);
  }
}

DEV void p0_mod(const Params& p, int idx, float* sm) {
  const int tid = otid();
  int l = idx / 48, jb = idx % 48;
  float* sc = sm;
  float* red = sm + 3072;
  for (int e = tid; e < 3072; e += NT) {
    int cond = e >> 10, i = e & 1023;
    float cv = cond == 0 ? p.in[I_CCTX][i] : p.in[I_C][(cond - 1) * 1024 + i];
    sc[e] = silu(cv);
  }
  __syncthreads();
  int jj = tid & 63, ig = tid >> 6;
  int j = jb * 64 + jj;
  const float* w = p.in[I_WADA] + (size_t)l * 1024 * 3072 + j;
  float a0 = 0.f, a1 = 0.f, a2 = 0.f;
#pragma unroll 8
  for (int i = ig * 256; i < ig * 256 + 256; ++i) {
    float wv = w[(size_t)i * 3072];
    a0 += wv * sc[i];
    a1 += wv * sc[1024 + i];
    a2 += wv * sc[2048 + i];
  }
  red[(0 * 4 + ig) * 64 + jj] = a0;
  red[(1 * 4 + ig) * 64 + jj] = a1;
  red[(2 * 4 + ig) * 64 + jj] = a2;
  __syncthreads();
  if (tid < 192) {
    int cond = tid >> 6, q = tid & 63;
    float s = red[(cond * 4 + 0) * 64 + q] + red[(cond * 4 + 1) * 64 + q] + red[(cond * 4 + 2) * 64 + q] +
              red[(cond * 4 + 3) * 64 + q];
    int jo = jb * 64 + q;
    s += p.in[I_BADA][l * 3072 + jo];
    ((float*)(p.ws + OFF_MOD))[(l * 3 + cond) * 3072 + jo] = s;
  }
  __syncthreads();
}

DEV void p0_misc(const Params& p) {
  const int tid = otid();
  float* rope = (float*)(p.ws + OFF_ROPE);
  for (int e = tid; e < 1024; e += NT) {
    int pos = e >> 4, jj = e & 15;
    float fr = powf(10000.0f, -(float)jj / 16.0f);
    float ang = (float)pos * fr;
    rope[e * 2] = cosf(ang);
    rope[e * 2 + 1] = sinf(ang);
  }
  if (tid < 4) {
    int l = tid;
    float s1 = 0.f, s2 = 0.f;
    for (int i = 0; i < 64; ++i) {
      s1 += p.in[I_LQ1][l * 64 + i] * p.in[I_LK1][l * 64 + i];
      s2 += p.in[I_LQ2][l * 64 + i] * p.in[I_LK2][l * 64 + i];
    }
    float li = 0.8f - 0.6f * expf(-0.3f * (float)l);
    float* lam = (float*)(p.ws + OFF_LAM);
    lam[l] = expf(s1) - expf(s2) + li;
    lam[4 + l] = li;
  }
}

DEV void p0_filter(const Params& p, int idx, float* sm) {
  const int tid = otid();
  int l = idx / 288, r = idx % 288;
  int L, d0, rowbase;
  if (r < 32) { L = 256; d0 = r * 8; rowbase = 0; } else { L = 2048; d0 = (r - 32) * 8; rowbase = 512; }
  float* zf = sm;
  float* h1 = sm + 272;
  float* h2 = h1 + 512;
  for (int e = tid; e < 264; e += NT) {
    int pp = e / 33, f = e % 33;
    int d = d0 + pp;
    float val;
    if (f == 0) {
      val = (float)d / (float)(L - 1);
    } else {
      float w = 6.283185307179586f * (float)d / (float)L;
      int bj = (f - 1) & 15;
      float band = 1e-4f + (float)bj * ((15.0f - 1e-4f) / 15.0f);
      float ang = band * w;
      val = (f <= 16) ? cosf(ang) : -sinf(ang);
    }
    zf[pp * 33 + f] = val;
  }
  __syncthreads();
  const float* f1 = p.in[I_HF1] + l * 33 * 64;
  const float* fb1 = p.in[I_HFB1] + l * 64;
  const float* fq = p.in[I_HFREQ] + l * 64;
  const float* f2 = p.in[I_HF2] + l * 64 * 64;
  const float* fb2 = p.in[I_HFB2] + l * 64;
  const float* f3 = p.in[I_HF3] + (size_t)l * 64 * 1024;
#pragma unroll
  for (int q = 0; q < 2; ++q) {
    int v = tid + 256 * q, pp = v >> 6, j = v & 63;
    float s = fb1[j];
#pragma unroll 11
    for (int f = 0; f < 33; ++f) s += zf[pp * 33 + f] * f1[f * 64 + j];
    h1[v] = sinf(fq[j] * s);
  }
  __syncthreads();
#pragma unroll
  for (int q = 0; q < 2; ++q) {
    int v = tid + 256 * q, pp = v >> 6, j = v & 63;
    float s = fb2[j];
#pragma unroll 16
    for (int i = 0; i < 64; ++i) s += h1[pp * 64 + i] * f2[i * 64 + j];
    h2[v] = sinf(fq[j] * s);
  }
  __syncthreads();
  bf16_t* GRb = (bf16_t*)((unsigned*)(p.ws + OFF_G) + (size_t)l * GR_LAYER_DW + (rowbase ? GR_CTX_DW : 0));
  const int CL = 2 * L + 32;
  const float dmin = 3.0701134573253944f, dmax = 15.350567286626972f;
  for (int q = 0; q < 4; ++q) {
    int o = tid + 256 * q;
    float acc[8];
#pragma unroll
    for (int pp = 0; pp < 8; ++pp) acc[pp] = 0.f;
#pragma unroll 8
    for (int j = 0; j < 64; ++j) {
      float wv = f3[j * 1024 + o];
#pragma unroll
      for (int pp = 0; pp < 8; ++pp) acc[pp] += h2[pp * 64 + j] * wv;
    }
    int c = o & 511;
    float delta = dmin + (float)c * ((dmax - dmin) / 511.0f);
    bf16_t* c0 = GRb + (size_t)(c * 2) * CL;
    bf16_t* c1 = c0 + CL;
#pragma unroll
    for (int pp = 0; pp < 8; ++pp) {
      int d = d0 + pp;
      float t = (float)d / (float)(L - 1);
      float val = acc[pp] * __expf(-t * delta);
      if (o < 512) {
        if (d == 0) val += p.in[I_HBIAS][l * 512 + c];
        int qq = L - d;
        bf16_t hv = f2bf(val);
        c0[qq] = hv;
        c1[qq - 1] = hv;
      } else if (d >= 1) {
        int qq = L + d;
        bf16_t hv = f2bf(val);
        c0[qq] = hv;
        c1[qq - 1] = hv;
      }
    }
    if (d0 == 0 && o < 512) {
      c0[0] = 0;
      for (int x = 2 * L; x < CL; ++x) c0[x] = 0;
      for (int x = 2 * L - 1; x < CL; ++x) c1[x] = 0;
    }
  }
  __syncthreads();
}

DEV void norm_item(const Params& p, int l, int idx) {
  const int tid = otid(), lane = tid & 63, wid = tid >> 6;
  float4 v[2][4];
  const float* g = p.in[I_NORMG] + l * 1024;
#pragma unroll
  for (int u = 0; u < 2; ++u) {
    int m = idx * 8 + u * 4 + wid;
    const float* x;
    if (l == 0) x = (m < 4096) ? p.in[I_XP] + (size_t)m * 1024 : p.in[I_XS] + (size_t)(m - 4096) * 1024;
    else x = p.out + (size_t)m * 1024;
#pragma unroll
    for (int i = 0; i < 4; ++i) v[u][i] = *(const float4*)(x + i * 256 + lane * 4);
  }
#pragma unroll
  for (int u = 0; u < 2; ++u) {
    int m = idx * 8 + u * 4 + wid;
    float ss = 0.f;
#pragma unroll
    for (int i = 0; i < 4; ++i)
      ss += v[u][i].x * v[u][i].x + v[u][i].y * v[u][i].y + v[u][i].z * v[u][i].z + v[u][i].w * v[u][i].w;
    ss = wave_sum(ss);
    float rinv = rsqrtf(ss * (1.0f / 1024.0f) + 1e-6f);
    const float* mod = (const float*)(p.ws + OFF_MOD) + (l * 3 + condof(m)) * 3072;
    bf16_t* h = (bf16_t*)(p.ws + OFF_H) + (size_t)m * 1024;
#pragma unroll
    for (int i = 0; i < 4; ++i) {
      int c = i * 256 + lane * 4;
      float4 gg = *(const float4*)(g + c);
      float4 sh = *(const float4*)(mod + c);
      float4 sc = *(const float4*)(mod + 1024 + c);
      float o0 = v[u][i].x * rinv * gg.x * (1.f + sc.x) + sh.x;
      float o1 = v[u][i].y * rinv * gg.y * (1.f + sc.y) + sh.y;
      float o2 = v[u][i].z * rinv * gg.z * (1.f + sc.z) + sh.z;
      float o3 = v[u][i].w * rinv * gg.w * (1.f + sc.w) + sh.w;
      uint2 pk;
      pk.x = pack2(o0, o1);
      pk.y = pack2(o2, o3);
      *(uint2*)(h + c) = pk;
    }
  }
}

template <int MTW>
DEV void gemm_kloop(const bf16_t* __restrict__ Wg, const bf16_t* __restrict__ Xg, int K, f32x4 (&acc)[4][MTW],
                    bf16_t* sm) {
  const int tid = otid(), lane = tid & 63, wid = tid >> 6, wn = wid >> 1, wm = wid & 1, fr = lane & 15,
            fq = lane >> 4;
  constexpr int XR = MTW / 2;
  bf16_t* sW = sm;
  bf16_t* sX = sm + 2 * 5120;
  uint4 rwA0, rwA1, rxA0, rxA1, rwB0, rwB1, rxB0, rxB1, rwC0, rwC1, rxC0, rxC1, rwD0, rwD1, rxD0, rxD1;
  rxA1 = rxB1 = rxC1 = rxD1 = uint4{0u, 0u, 0u, 0u};
  const int r0 = tid >> 2, kc = (tid & 3) * 8;
  const bf16_t* wp = Wg + (size_t)r0 * K + kc;
  const bf16_t* xp = Xg + (size_t)r0 * K + kc;
  const size_t step64 = (size_t)64 * K;
  const bf16_t* cWb = sW + (wn * 64 + fr) * 40 + fq * 8;
  const bf16_t* cXb = sX + (wm * (MTW * 16) + fr) * 40 + fq * 8;
#define GEMM_GL(S, kt_)                                                            \
  {                                                                                \
    const int ko_ = (kt_) * 32;                                                    \
    rw##S##0 = *(const uint4*)(wp + ko_);                                          \
    rw##S##1 = *(const uint4*)(wp + step64 + ko_);                                 \
    rx##S##0 = *(const uint4*)(xp + ko_);                                          \
    if constexpr (XR == 2) rx##S##1 = *(const uint4*)(xp + step64 + ko_);          \
  }
#define GEMM_SW(S, buf_)                                                           \
  {                                                                                \
    bf16_t* dW_ = sW + (buf_) * 5120;                                              \
    bf16_t* dX_ = sX + (buf_) * 5120;                                              \
    *(uint4*)(dW_ + r0 * 40 + kc) = rw##S##0;                                      \
    *(uint4*)(dW_ + (r0 + 64) * 40 + kc) = rw##S##1;                               \
    *(uint4*)(dX_ + r0 * 40 + kc) = rx##S##0;                                      \
    if constexpr (XR == 2) *(uint4*)(dX_ + (r0 + 64) * 40 + kc) = rx##S##1;        \
  }
  auto mma = [&](int buf) {
    const bf16_t* cW = cWb + buf * 5120;
    const bf16_t* cX = cXb + buf * 5120;
    bf16x8 a[4], bb[MTW];
#pragma unroll
    for (int i = 0; i < 4; ++i) a[i] = *(const bf16x8*)(cW + i * 16 * 40);
#pragma unroll
    for (int i = 0; i < MTW; ++i) bb[i] = *(const bf16x8*)(cX + i * 16 * 40);
#pragma unroll
    for (int nt = 0; nt < 4; ++nt)
#pragma unroll
      for (int mt = 0; mt < MTW; ++mt)
        acc[nt][mt] = __builtin_amdgcn_mfma_f32_16x16x32_bf16(a[nt], bb[mt], acc[nt][mt], 0, 0, 0);
  };
  const int nk = K >> 5;
  GEMM_GL(A, 0);
  GEMM_GL(B, 1);
  GEMM_GL(C, 2);
  GEMM_GL(D, 3);
  GEMM_SW(A, 0);
  __syncthreads();
  for (int kt = 0; kt < nk; kt += 4) {
    const bool more4 = (kt + 4 < nk);
    if (more4) GEMM_GL(A, kt + 4);
    mma(0);
    GEMM_SW(B, 1);
    __syncthreads();
    if (more4) GEMM_GL(B, kt + 5);
    mma(1);
    GEMM_SW(C, 0);
    __syncthreads();
    if (more4) GEMM_GL(C, kt + 6);
    mma(0);
    GEMM_SW(D, 1);
    __syncthreads();
    if (more4) GEMM_GL(D, kt + 7);
    mma(1);
    if (more4) GEMM_SW(A, 0);
    __syncthreads();
  }
#undef GEMM_GL
#undef GEMM_SW
}

DEV void gemm_in_tile(const Params& p, int l, int tile, bf16_t* sm) {
  const int tid = otid(), lane = tid & 63, wid = tid >> 6, wn = wid >> 1, wm = wid & 1, fr = lane & 15,
            fq = lane >> 4;
  int mt_ = tile & 63, nt_ = tile >> 6;
  int m0 = mt_ * 128, n0 = nt_ * 128;
  f32x4 acc[4][4];
#pragma unroll
  for (int a = 0; a < 4; ++a)
#pragma unroll
    for (int b = 0; b < 4; ++b) acc[a][b] = f32x4{0.f, 0.f, 0.f, 0.f};
  const bf16_t* Wt = (const bf16_t*)(p.ws + OFF_WTIN) + ((size_t)l * NIN + n0) * 1024;
  const bf16_t* X = (const bf16_t*)(p.ws + OFF_H) + (size_t)m0 * 1024;
  gemm_kloop<4>(Wt, X, 1024, acc, sm);
  bf16_t* z = (bf16_t*)(p.ws + OFF_Z);
#pragma unroll
  for (int nt = 0; nt < 4; ++nt)
#pragma unroll
    for (int mt = 0; mt < 4; ++mt) {
      int n = n0 + wn * 64 + nt * 16 + fq * 4;
      int m = m0 + wm * 64 + mt * 16 + fr;
      uint2 pk;
      pk.x = pack2(acc[nt][mt][0], acc[nt][mt][1]);
      pk.y = pack2(acc[nt][mt][2], acc[nt][mt][3]);
      *(uint2*)(z + (size_t)m * NIN + n) = pk;
    }
}

template <int MTW>
DEV void gemm_kloop2(const bf16_t* __restrict__ Wg, const bf16_t* __restrict__ Xg, int K, f32x4 (&acc)[4][MTW],
                    bf16_t* sm) {
  const int tid = otid(), lane = tid & 63, wid = tid >> 6, wn = wid >> 1, wm = wid & 1, fr = lane & 15,
            fq = lane >> 4;
  constexpr int XR = MTW / 2;
  bf16_t* sW = sm;
  bf16_t* sX = sm + 2 * 5120;
  uint4 rwE0, rwE1, rxE0, rxE1, rwO0, rwO1, rxO0, rxO1;
  rxE1 = rxO1 = uint4{0u, 0u, 0u, 0u};
  const int r0 = tid >> 2, kc = (tid & 3) * 8;
  const bf16_t* wp = Wg + (size_t)r0 * K + kc;
  const bf16_t* xp = Xg + (size_t)r0 * K + kc;
  const size_t step64 = (size_t)64 * K;
  const bf16_t* cWb = sW + (wn * 64 + fr) * 40 + fq * 8;
  const bf16_t* cXb = sX + (wm * (MTW * 16) + fr) * 40 + fq * 8;
#define GEMM_GL(S, kt_)                                                            \
  {                                                                                \
    const int ko_ = (kt_) * 32;                                                    \
    rw##S##0 = *(const uint4*)(wp + ko_);                                          \
    rw##S##1 = *(const uint4*)(wp + step64 + ko_);                                 \
    rx##S##0 = *(const uint4*)(xp + ko_);                                          \
    if constexpr (XR == 2) rx##S##1 = *(const uint4*)(xp + step64 + ko_);          \
  }
#define GEMM_SW(S, buf_)                                                           \
  {                                                                                \
    bf16_t* dW_ = sW + (buf_) * 5120;                                              \
    bf16_t* dX_ = sX + (buf_) * 5120;                                              \
    *(uint4*)(dW_ + r0 * 40 + kc) = rw##S##0;                                      \
    *(uint4*)(dW_ + (r0 + 64) * 40 + kc) = rw##S##1;                               \
    *(uint4*)(dX_ + r0 * 40 + kc) = rx##S##0;                                      \
    if constexpr (XR == 2) *(uint4*)(dX_ + (r0 + 64) * 40 + kc) = rx##S##1;        \
  }
  auto mma = [&](int buf) {
    const bf16_t* cW = cWb + buf * 5120;
    const bf16_t* cX = cXb + buf * 5120;
    bf16x8 a[4], bb[MTW];
#pragma unroll
    for (int i = 0; i < 4; ++i) a[i] = *(const bf16x8*)(cW + i * 16 * 40);
#pragma unroll
    for (int i = 0; i < MTW; ++i) bb[i] = *(const bf16x8*)(cX + i * 16 * 40);
#pragma unroll
    for (int nt = 0; nt < 4; ++nt)
#pragma unroll
      for (int mt = 0; mt < MTW; ++mt)
        acc[nt][mt] = __builtin_amdgcn_mfma_f32_16x16x32_bf16(a[nt], bb[mt], acc[nt][mt], 0, 0, 0);
  };
  const int nk = K >> 5;
  GEMM_GL(E, 0);
  GEMM_GL(O, 1);
  GEMM_SW(E, 0);
  __syncthreads();
  for (int kt = 0; kt < nk; kt += 2) {
    const bool more2 = (kt + 2 < nk);
    if (more2) GEMM_GL(E, kt + 2);
    mma(0);
    GEMM_SW(O, 1);
    __syncthreads();
    if (kt + 3 < nk) GEMM_GL(O, kt + 3);
    mma(1);
    if (more2) GEMM_SW(E, 0);
    __syncthreads();
  }
#undef GEMM_GL
#undef GEMM_SW
}

DEV void gemm_br_tile(const Params& p, int l, int tile, bf16_t* sm) {
  const int tid = otid(), lane = tid & 63, wid = tid >> 6, wn = wid >> 1, wm = wid & 1, fr = lane & 15,
            fq = lane >> 4;
  int mt_ = tile & 63, nt_ = tile >> 6;
  int m0 = mt_ * 128, n0 = nt_ * 128;
  f32x4 tot[4][4];
#pragma unroll
  for (int a = 0; a < 4; ++a)
#pragma unroll
    for (int b = 0; b < 4; ++b) tot[a][b] = f32x4{0.f, 0.f, 0.f, 0.f};
  const bf16_t* z = (const bf16_t*)(p.ws + OFF_Z);
#pragma unroll 1
  for (int br = 0; br < 3; ++br) {
    asm volatile("" ::: "memory");
    f32x4 acc[4][4];
#pragma unroll
    for (int a = 0; a < 4; ++a)
#pragma unroll
      for (int b = 0; b < 4; ++b) acc[a][b] = f32x4{0.f, 0.f, 0.f, 0.f};
    const bf16_t* Wt = (const bf16_t*)(p.ws + OFF_WTBR) + ((size_t)(l * 3 + br) * 1024 + n0) * 512;
    const bf16_t* X = (const bf16_t*)(p.ws + OFF_YA + (size_t)br * MTOK * 512 * 2) + (size_t)m0 * 512;
    gemm_kloop2<4>(Wt, X, 512, acc, sm);
#pragma unroll
    for (int nt = 0; nt < 4; ++nt)
#pragma unroll
      for (int mt = 0; mt < 4; ++mt) {
        int n = n0 + wn * 64 + nt * 16 + fq * 4;
        int m = m0 + wm * 64 + mt * 16 + fr;
        uint2 g = *(const uint2*)(z + (size_t)m * NIN + C_MG + br * 1024 + n);
        tot[nt][mt][0] += sigm(bflo(g.x)) * acc[nt][mt][0];
        tot[nt][mt][1] += sigm(bfhi(g.x)) * acc[nt][mt][1];
        tot[nt][mt][2] += sigm(bflo(g.y)) * acc[nt][mt][2];
        tot[nt][mt][3] += sigm(bfhi(g.y)) * acc[nt][mt][3];
      }
  }
  bf16_t* mg = (bf16_t*)(p.ws + OFF_H);
#pragma unroll
  for (int nt = 0; nt < 4; ++nt)
#pragma unroll
    for (int mt = 0; mt < 4; ++mt) {
      int n = n0 + wn * 64 + nt * 16 + fq * 4;
      int m = m0 + wm * 64 + mt * 16 + fr;
      uint2 pk;
      pk.x = pack2(tot[nt][mt][0], tot[nt][mt][1]);
      pk.y = pack2(tot[nt][mt][2], tot[nt][mt][3]);
      *(uint2*)(mg + (size_t)m * 1024 + n) = pk;
    }
}

DEV void gemm_out_tile(const Params& p, int l, int tile, bf16_t* sm) {
  const int tid = otid(), lane = tid & 63, wid = tid >> 6, wn = wid >> 1, wm = wid & 1, fr = lane & 15,
            fq = lane >> 4;
  int mt_ = tile & 63, nt_ = tile >> 6;
  int m0 = mt_ * 128, n0 = nt_ * 128;
  f32x4 acc[4][4];
#pragma unroll
  for (int a = 0; a < 4; ++a)
#pragma unroll
    for (int b = 0; b < 4; ++b) acc[a][b] = f32x4{0.f, 0.f, 0.f, 0.f};
  const bf16_t* Wt = (const bf16_t*)(p.ws + OFF_WTOUT) + ((size_t)l * 1024 + n0) * 1024;
  const bf16_t* X = (const bf16_t*)(p.ws + OFF_H) + (size_t)m0 * 1024;
  gemm_kloop<4>(Wt, X, 1024, acc, sm);
  const float* gate = (const float*)(p.ws + OFF_MOD) + (l * 3 + condof(m0)) * 3072 + 2048;
#pragma unroll
  for (int nt = 0; nt < 4; ++nt)
#pragma unroll
    for (int mt = 0; mt < 4; ++mt) {
      int n = n0 + wn * 64 + nt * 16 + fq * 4;
      int m = m0 + wm * 64 + mt * 16 + fr;
      const float* xin;
      if (l == 0) xin = (m < 4096) ? p.in[I_XP] + (size_t)m * 1024 : p.in[I_XS] + (size_t)(m - 4096) * 1024;
      else xin = p.out + (size_t)m * 1024;
      float4 xv = *(const float4*)(xin + n);
      float4 gv = *(const float4*)(gate + n);
      float4 o;
      o.x = xv.x + gv.x * acc[nt][mt][0];
      o.y = xv.y + gv.y * acc[nt][mt][1];
      o.z = xv.z + gv.z * acc[nt][mt][2];
      o.w = xv.w + gv.w * acc[nt][mt][3];
      *(float4*)(p.out + (size_t)m * 1024 + n) = o;
    }
}

DEV void prep_hyena(const Params& p, int l, int idx) {
  const int tid = otid();
  const int c2 = tid * 2;
  const bf16_t* z = (const bf16_t*)(p.ws + OFF_Z);
  const float* cw = p.in[I_HCW] + l * 3 * 1536;
  const float* cb = p.in[I_HCB] + l * 1536;
  bf16_t* ut = (bf16_t*)(p.ws + OFF_H);
  float* x1b = (float*)(p.ws + OFF_X1);
  v2f w0[3], w1[3], w2[3], bb[3];
#pragma unroll
  for (int pt = 0; pt < 3; ++pt) {
    int col = pt * 512 + c2;
    w0[pt] = *(const v2f*)(cw + col);
    w1[pt] = *(const v2f*)(cw + 1536 + col);
    w2[pt] = *(const v2f*)(cw + 3072 + col);
    bb[pt] = *(const v2f*)(cb + col);
  }
  const int m0 = idx * 16;
  unsigned ua[8], ub[8];
  v2f x1r[16];
  float pa = 0.f, pb = 0.f;
#pragma unroll
  for (int i = 0; i < 16; ++i) {
    int m = m0 + i, t, L;
    tokinfo(m, t, L);
    v2f u[3];
#pragma unroll
    for (int pt = 0; pt < 3; ++pt) {
      int col = C_HYZ + pt * 512 + c2;
      unsigned z0 = *(const unsigned*)(z + (size_t)m * NIN + col);
      unsigned zm = (t > 0) ? *(const unsigned*)(z + (size_t)(m - 1) * NIN + col) : 0u;
      unsigned zp = (t < L - 1) ? *(const unsigned*)(z + (size_t)(m + 1) * NIN + col) : 0u;
      v2f a = v2f{bflo(zm), bfhi(zm)}, b = v2f{bflo(z0), bfhi(z0)}, c = v2f{bflo(zp), bfhi(zp)};
      u[pt] = a * w0[pt] + b * w1[pt] + c * w2[pt] + bb[pt];
    }
    v2f uu = u[2] * u[0];
    x1r[i] = u[1];
    if (i & 1) {
      ua[i >> 1] = pack2(pa, uu.x);
      ub[i >> 1] = pack2(pb, uu.y);
    } else {
      pa = uu.x;
      pb = uu.y;
    }
  }
#pragma unroll
  for (int i = 0; i < 16; ++i) *(v2f*)(x1b + (size_t)(m0 + i) * 512 + c2) = x1r[i];
  bf16_t* d0 = ut + (size_t)c2 * MTOK + m0;
  bf16_t* d1 = d0 + MTOK;
  *(uint4*)(d0) = uint4{ua[0], ua[1], ua[2], ua[3]};
  *(uint4*)(d0 + 8) = uint4{ua[4], ua[5], ua[6], ua[7]};
  *(uint4*)(d1) = uint4{ub[0], ub[1], ub[2], ub[3]};
  *(uint4*)(d1 + 8) = uint4{ub[4], ub[5], ub[6], ub[7]};
}

DEV float zr_mix(const bf16_t* z, const float* mu, int m, int t, int L, int cc) {
  int col = C_RWZ + cc;
  float z0 = bf2f(z[(size_t)m * NIN + col]);
  float zm = (t > 0) ? bf2f(z[(size_t)(m - 1) * NIN + col]) : 0.f;
  float zp = (t < L - 1) ? bf2f(z[(size_t)(m + 1) * NIN + col]) : 0.f;
  return z0 + mu[cc] * (0.5f * (zm + zp) - z0);
}

DEV void prep_rwkv(const Params& p, int l, int idx, float* sm) {
  const int tid = otid();
  const bf16_t* z = (const bf16_t*)(p.ws + OFF_Z);
  const float* mu = p.in[I_RMU] + l * 1792;
  const int m0 = idx * 8;
  float* lora = sm;
  {
    int tk = tid >> 5, cc0 = (tid & 31) * 8;
    int m = m0 + tk, t, L;
    tokinfo(m, t, L);
#pragma unroll
    for (int e = 0; e < 8; ++e) {
      int cc = cc0 + e;
      float val = zr_mix(z, mu, m, t, L, 1536 + cc);
      int type = cc >> 6, j = cc & 63;
      if (type < 2) val = 1.f - 2.f * __builtin_amdgcn_rcpf(1.f + __expf(2.f * val));
      lora[(j * 4 + type) * 8 + tk] = val;
    }
  }
  __syncthreads();
  float* R = (float*)(p.ws + OFF_R);
  float* KK = (float*)(p.ws + OFF_KK);
  float* V = (float*)(p.ws + OFF_V);
  float* W = (float*)(p.ws + OFF_W);
  float* BV = (float*)(p.ws + OFF_BV);
  float* KD = (float*)(p.ws + OFF_KD);
  const size_t DSTR = (size_t)MTOK * 512;
  float acc[2][4][8];
#pragma unroll
  for (int s = 0; s < 2; ++s)
#pragma unroll
    for (int ty = 0; ty < 4; ++ty)
#pragma unroll
      for (int tk = 0; tk < 8; ++tk) acc[s][ty][tk] = 0.f;
  {
    const float* w2 = p.in[I_RW2] + (size_t)l * 2 * 64 * 512 + tid;
    const float* a2 = p.in[I_RA2] + (size_t)l * 2 * 64 * 512 + tid;
#pragma unroll 4
    for (int j = 0; j < 64; ++j) {
      float wv[2][4];
#pragma unroll
      for (int s = 0; s < 2; ++s) {
        wv[s][0] = w2[j * 512 + 256 * s];
        wv[s][1] = w2[(64 + j) * 512 + 256 * s];
        wv[s][2] = a2[j * 512 + 256 * s];
        wv[s][3] = a2[(64 + j) * 512 + 256 * s];
      }
#pragma unroll
      for (int ty = 0; ty < 4; ++ty) {
        float4 l0 = *(const float4*)(lora + (j * 4 + ty) * 8);
        float4 l1 = *(const float4*)(lora + (j * 4 + ty) * 8 + 4);
#pragma unroll
        for (int s = 0; s < 2; ++s) {
          acc[s][ty][0] += l0.x * wv[s][ty];
          acc[s][ty][1] += l0.y * wv[s][ty];
          acc[s][ty][2] += l0.z * wv[s][ty];
          acc[s][ty][3] += l0.w * wv[s][ty];
          acc[s][ty][4] += l1.x * wv[s][ty];
          acc[s][ty][5] += l1.y * wv[s][ty];
          acc[s][ty][6] += l1.z * wv[s][ty];
          acc[s][ty][7] += l1.w * wv[s][ty];
        }
      }
    }
  }
#pragma unroll
  for (int s = 0; s < 2; ++s) {
    int c = tid + 256 * s;
    float rr[8], kr[8], vr[8];
#pragma unroll
    for (int tk = 0; tk < 8; ++tk) {
      int m = m0 + tk, t, L;
      tokinfo(m, t, L);
      rr[tk] = zr_mix(z, mu, m, t, L, c);
      kr[tk] = zr_mix(z, mu, m, t, L, 512 + c);
      vr[tk] = zr_mix(z, mu, m, t, L, 1024 + c);
    }
    float w00 = p.in[I_RW0][(l * 2 + 0) * 512 + c], w01 = p.in[I_RW0][(l * 2 + 1) * 512 + c];
    float a00 = p.in[I_RA0][(l * 2 + 0) * 512 + c], a01 = p.in[I_RA0][(l * 2 + 1) * 512 + c];
    float kkw = p.in[I_RKK][l * 512 + c], kaw = p.in[I_RKA][l * 512 + c];
#pragma unroll
    for (int tk = 0; tk < 8; ++tk) {
      int m = m0 + tk;
      float r = rr[tk], k = kr[tk], v = vr[tk];
      float kk = k * kkw;
      float ss = wave_sum(kk * kk);
      kk = kk * rsqrtf(ss + 1e-12f);
      float wd0 = __expf(-0.6065306597126334f * sigm(w00 + acc[s][0][tk]));
      float wd1 = __expf(-0.6065306597126334f * sigm(w01 + acc[s][1][tk]));
      float ad0 = sigm(a00 + acc[s][2][tk]);
      float ad1 = sigm(a01 + acc[s][3][tk]);
      size_t o = (size_t)m * 512 + c;
      R[o] = r;
      KK[o] = kk;
      V[o] = v;
      W[o] = wd0;
      W[DSTR + o] = wd1;
      BV[o] = kk * ad0;
      BV[DSTR + o] = kk * ad1;
      KD[o] = k * (1.f + (ad0 - 1.f) * kaw);
      KD[DSTR + o] = k * (1.f + (ad1 - 1.f) * kaw);
    }
  }
  __syncthreads();
}

DEV void prep_qk(const Params& p, int l, int idx) {
  const int tid = otid();
  int gid = idx * 256 + tid;
  int m = gid >> 4, chunk = gid & 15;
  const bool isk = chunk >= 8;
  const int ch8 = chunk & 7;
  const bf16_t* z = (const bf16_t*)(p.ws + OFF_Z) + (size_t)m * NIN + (isk ? C_DAK : C_DAQ) + ch8 * 64;
  float x[64];
  float ss = 0.f;
#pragma unroll
  for (int i = 0; i < 8; ++i) {
    uint4 u = *(const uint4*)(z + i * 8);
    x[i * 8 + 0] = bflo(u.x); x[i * 8 + 1] = bfhi(u.x);
    x[i * 8 + 2] = bflo(u.y); x[i * 8 + 3] = bfhi(u.y);
    x[i * 8 + 4] = bflo(u.z); x[i * 8 + 5] = bfhi(u.z);
    x[i * 8 + 6] = bflo(u.w); x[i * 8 + 7] = bfhi(u.w);
  }
#pragma unroll
  for (int i = 0; i < 64; ++i) ss += x[i] * x[i];
  float rinv = rsqrtf(ss * (1.0f / 64.0f) + 1e-6f);
  const float* g = (isk ? p.in[I_GK] : p.in[I_GQ]) + l * 64;
#pragma unroll
  for (int i = 0; i < 64; ++i) x[i] = x[i] * rinv * g[i];
  int t, L;
  tokinfo(m, t, L);
  if (m < 4096) {
    if (isk) {
      int b = m >> 8;
      float* ck = p.out + O_CK + ((size_t)(b * 4 + l) * 256 + t) * 512 + ch8 * 64;
#pragma unroll
      for (int i = 0; i < 16; ++i) *(float4*)(ck + i * 4) = float4{x[i * 4], x[i * 4 + 1], x[i * 4 + 2], x[i * 4 + 3]};
    }
  } else {
    const float* rope = (const float*)(p.ws + OFF_ROPE);
    int row = t >> 6, colp = t & 63;
#pragma unroll
    for (int jj = 0; jj < 16; ++jj) {
      float c1 = rope[(row * 16 + jj) * 2], s1 = rope[(row * 16 + jj) * 2 + 1];
      float a = x[jj], b = x[16 + jj];
      x[jj] = a * c1 - b * s1;
      x[16 + jj] = a * s1 + b * c1;
      float c2 = rope[(colp * 16 + jj) * 2], s2 = rope[(colp * 16 + jj) * 2 + 1];
      float a2 = x[32 + jj], b2 = x[48 + jj];
      x[32 + jj] = a2 * c2 - b2 * s2;
      x[48 + jj] = a2 * s2 + b2 * c2;
    }
  }
  bf16_t* dst;
  if (!isk) {
#pragma unroll
    for (int i = 0; i < 64; ++i) x[i] *= 0.125f;
    dst = (bf16_t*)(p.ws + OFF_Q) + (size_t)m * 512 + ch8 * 64;
  } else {
    size_t krow = (m < 4096) ? (size_t)m : (size_t)4096 + (size_t)((m - 4096) >> 11) * 2304 + 256 + t;
    dst = (bf16_t*)(p.ws + OFF_K) + krow * 512 + ch8 * 64;
  }
#pragma unroll
  for (int i = 0; i < 8; ++i) {
    uint4 u;
    u.x = pack2(x[i * 8 + 0], x[i * 8 + 1]);
    u.y = pack2(x[i * 8 + 2], x[i * 8 + 3]);
    u.z = pack2(x[i * 8 + 4], x[i * 8 + 5]);
    u.w = pack2(x[i * 8 + 6], x[i * 8 + 7]);
    *(uint4*)(dst + i * 8) = u;
  }
}

DEV void prep_kcache(const Params& p, int l, int idx) {
  const int tid = otid();
  int gid = idx * 256 + tid;
  int b = gid >> 11, pp = (gid >> 3) & 255, ch8 = gid & 7;
  const float* src = p.in[I_CK] + ((size_t)(b * 4 + l) * 256 + pp) * 512 + ch8 * 64;
  bf16_t* dst = (bf16_t*)(p.ws + OFF_K) + ((size_t)4096 + (size_t)b * 2304 + pp) * 512 + ch8 * 64;
#pragma unroll
  for (int i = 0; i < 8; ++i) {
    float4 a = *(const float4*)(src + i * 8), c = *(const float4*)(src + i * 8 + 4);
    uint4 u;
    u.x = pack2(a.x, a.y); u.y = pack2(a.z, a.w); u.z = pack2(c.x, c.y); u.w = pack2(c.z, c.w);
    *(uint4*)(dst + i * 8) = u;
  }
}

DEV void prep_vt(const Params& p, int l, int idx, bf16_t* sv) {
  const int tid = otid();
  int h, kt, Lk;
  bf16_t* vt;
  const int i = tid >> 2, dq = (tid & 3) * 32;
  bf16_t* srow = sv + i * 136 + dq;
  if (idx < 256) {
    int seq = idx >> 4;
    h = (idx >> 2) & 3; kt = idx & 3; Lk = 256;
    vt = (bf16_t*)(p.ws + OFF_VT) + (size_t)(seq * 4 + h) * 128 * 256;
    int t = kt * 64 + i;
    int m = seq * 256 + t;
    const bf16_t* src = (const bf16_t*)(p.ws + OFF_Z) + (size_t)m * NIN + C_DAV + h * 128 + dq;
    float* cv = p.out + O_CV + ((size_t)(seq * 4 + l) * 256 + t) * 512 + h * 128 + dq;
#pragma unroll
    for (int e = 0; e < 4; ++e) {
      uint4 u = *(const uint4*)(src + e * 8);
      *(uint4*)(srow + e * 8) = u;
      *(float4*)(cv + e * 8) = float4{bflo(u.x), bfhi(u.x), bflo(u.y), bfhi(u.y)};
      *(float4*)(cv + e * 8 + 4) = float4{bflo(u.z), bfhi(u.z), bflo(u.w), bfhi(u.w)};
    }
  } else {
    int r = idx - 256;
    int b = r / 144;
    h = (r / 36) & 3; kt = r % 36; Lk = 2304;
    vt = (bf16_t*)(p.ws + OFF_VT) + (size_t)4096 * 512 + (size_t)(b * 4 + h) * 128 * 2304;
    if (kt < 4) {
      const float* src = p.in[I_CV] + ((size_t)(b * 4 + l) * 256 + kt * 64 + i) * 512 + h * 128 + dq;
#pragma unroll
      for (int e = 0; e < 4; ++e) {
        float4 a = *(const float4*)(src + e * 8), c = *(const float4*)(src + e * 8 + 4);
        uint4 u;
        u.x = pack2(a.x, a.y); u.y = pack2(a.z, a.w); u.z = pack2(c.x, c.y); u.w = pack2(c.z, c.w);
        *(uint4*)(srow + e * 8) = u;
      }
    } else {
      int m = 4096 + b * 2048 + (kt - 4) * 64 + i;
      const bf16_t* src = (const bf16_t*)(p.ws + OFF_Z) + (size_t)m * NIN + C_DAV + h * 128 + dq;
#pragma unroll
      for (int e = 0; e < 4; ++e) *(uint4*)(srow + e * 8) = *(const uint4*)(src + e * 8);
    }
  }
  __syncthreads();
  {
    int d = tid >> 1, half = tid & 1;
    bf16_t* dst = vt + (size_t)d * Lk + kt * 64 + half * 32;
#pragma unroll
    for (int e = 0; e < 4; ++e) {
      unsigned w[4];
#pragma unroll
      for (int q = 0; q < 4; ++q) {
        int k0 = half * 32 + e * 8 + q * 2;
        w[q] = (unsigned)sv[k0 * 136 + d] | ((unsigned)sv[(k0 + 1) * 136 + d] << 16);
      }
      *(uint4*)(dst + e * 8) = uint4{w[0], w[1], w[2], w[3]};
    }
  }
  __syncthreads();
}

DEV void scan_item(const Params& p, int l, int seqbase, int L, int b, bool is_ctx, int h, int d, int rq, float* sb) {
  const int tid = otid();
  const int vl = tid >> 4, kq = tid & 15;
  const int v = rq * 16 + vl;
  const size_t DSTR = (size_t)MTOK * 512;
  const float* W = (const float*)(p.ws + OFF_W) + d * DSTR;
  const float* BV = (const float*)(p.ws + OFF_BV) + d * DSTR;
  const float* KD = (const float*)(p.ws + OFF_KD) + d * DSTR;
  const float* KK = (const float*)(p.ws + OFF_KK);
  const float* R = (const float*)(p.ws + OFF_R);
  const float* V = (const float*)(p.ws + OFF_V);
  float* Y = (float*)(p.ws + OFF_Y) + d * DSTR;
  float4 S = float4{0.f, 0.f, 0.f, 0.f};
  if (!is_ctx) S = *(const float4*)(p.in[I_ST] + ((((size_t)(b * 4 + l) * 2 + d) * 8 + h) * 64 + v) * 64 + kq * 4);
  const int nch = L >> 4;
  float4 g0, g1, g2, g3, g4;
  float gv;
  {
    int sidx = vl;
    int t = d ? (L - 1 - sidx) : sidx;
    size_t m = (size_t)(seqbase + t);
    size_t off = m * 512 + h * 64 + kq * 4;
    g0 = *(const float4*)(W + off); g1 = *(const float4*)(KK + off); g2 = *(const float4*)(BV + off);
    g3 = *(const float4*)(KD + off); g4 = *(const float4*)(R + off);
    gv = V[m * 512 + h * 64 + rq * 16 + kq];
    float* dst = sb + vl * 336;
    *(float4*)(dst + kq * 4) = g0; *(float4*)(dst + 64 + kq * 4) = g1; *(float4*)(dst + 128 + kq * 4) = g2;
    *(float4*)(dst + 192 + kq * 4) = g3; *(float4*)(dst + 256 + kq * 4) = g4;
    dst[320 + kq] = gv;
  }
  __syncthreads();
  for (int c = 0; c < nch; ++c) {
    const bool more = (c + 1 < nch);
    if (more) {
      int sidx = (c + 1) * 16 + vl;
      int t = d ? (L - 1 - sidx) : sidx;
      size_t m = (size_t)(seqbase + t);
      size_t off = m * 512 + h * 64 + kq * 4;
      g0 = *(const float4*)(W + off); g1 = *(const float4*)(KK + off); g2 = *(const float4*)(BV + off);
      g3 = *(const float4*)(KD + off); g4 = *(const float4*)(R + off);
      gv = V[m * 512 + h * 64 + rq * 16 + kq];
    }
    const float* cur = sb + (c & 1) * (16 * 336);
    float ykeep = 0.f;
    float4 nw = *(const float4*)(cur + kq * 4);
    float4 nkk = *(const float4*)(cur + 64 + kq * 4);
    float4 nbv = *(const float4*)(cur + 128 + kq * 4);
    float4 nkd = *(const float4*)(cur + 192 + kq * 4);
    float4 nr = *(const float4*)(cur + 256 + kq * 4);
    float nvv = cur[320 + vl];
#pragma unroll
    for (int i = 0; i < 16; ++i) {
      const float4 w = nw, kk = nkk, bv = nbv, kd = nkd, r = nr;
      const float vv = nvv;
      if (i + 1 < 16) {
        const float* row = cur + (i + 1) * 336;
        nw = *(const float4*)(row + kq * 4);
        nkk = *(const float4*)(row + 64 + kq * 4);
        nbv = *(const float4*)(row + 128 + kq * 4);
        nkd = *(const float4*)(row + 192 + kq * 4);
        nr = *(const float4*)(row + 256 + kq * 4);
        nvv = row[320 + vl];
      }
      __builtin_amdgcn_sched_barrier(0);
      v2f pd = v2f{S.x, S.y} * v2f{kk.x, kk.y};
      pd = v2f{S.z, S.w} * v2f{kk.z, kk.w} + pd;
      float dot = dpp_sum16(pd.x + pd.y);
      S.x = S.x * w.x + vv * kd.x - dot * bv.x;
      S.y = S.y * w.y + vv * kd.y - dot * bv.y;
      S.z = S.z * w.z + vv * kd.z - dot * bv.z;
      S.w = S.w * w.w + vv * kd.w - dot * bv.w;
      v2f py = v2f{S.x, S.y} * v2f{r.x, r.y};
      py = v2f{S.z, S.w} * v2f{r.z, r.w} + py;
      float y = dpp_sum16(py.x + py.y);
      ykeep = (kq == i) ? y : ykeep;
      __builtin_amdgcn_sched_barrier(0);
    }
    {
      int sidx = c * 16 + kq;
      int t = d ? (L - 1 - sidx) : sidx;
      Y[(size_t)(seqbase + t) * 512 + h * 64 + v] = ykeep;
    }
    if (more) {
      float* dst = sb + ((c + 1) & 1) * (16 * 336) + vl * 336;
      *(float4*)(dst + kq * 4) = g0; *(float4*)(dst + 64 + kq * 4) = g1; *(float4*)(dst + 128 + kq * 4) = g2;
      *(float4*)(dst + 192 + kq * 4) = g3; *(float4*)(dst + 256 + kq * 4) = g4;
      dst[320 + kq] = gv;
    }
    __syncthreads();
  }
  if (is_ctx) {
    *(float4*)(p.out + O_ST + ((((size_t)(b * 4 + l) * 2 + d) * 8 + h) * 64 + v) * 64 + kq * 4) = S;
  }
}

DEV void attn_item(const Params& p, int l, int seqbase, int qt, int h, size_t krow0, int Lk, const bf16_t* vt,
                   bf16_t* sm) {
  const int tid = otid(), lane = tid & 63, wid = tid >> 6, fr = lane & 15, fq = lane >> 4;
  bf16_t* sK = sm;
  bf16_t* sV = sm + 64 * 136;
  const bf16_t* Kg = (const bf16_t*)(p.ws + OFF_K) + krow0 * 512 + h * 128;
  const int q0 = seqbase + qt * 64 + wid * 16;
  const bf16_t* Qg = (const bf16_t*)(p.ws + OFF_Q) + (size_t)(q0 + fr) * 512 + h * 128;
  bf16x8 qf[2][2];
#pragma unroll
  for (int mp = 0; mp < 2; ++mp)
#pragma unroll
    for (int ch = 0; ch < 2; ++ch) qf[mp][ch] = *(const bf16x8*)(Qg + mp * 64 + ch * 32 + fq * 8);
  f32x4 O[2][8];
#pragma unroll
  for (int mp = 0; mp < 2; ++mp)
#pragma unroll
    for (int dt = 0; dt < 8; ++dt) O[mp][dt] = f32x4{0.f, 0.f, 0.f, 0.f};
  float ls0 = 0.f, ls1 = 0.f;
  const int nkt = Lk >> 6;
  const int a_kr = tid >> 4, a_kc = (tid & 15) * 8;
  const int a_vr = tid >> 3, a_vc = (tid & 7) * 8;
  const bf16_t* kgp = Kg + (size_t)a_kr * 512 + a_kc;
  const bf16_t* vgp = vt + (size_t)a_vr * Lk + a_vc;
  uint4 pk0, pk1, pk2, pk3, pv0, pv1, pv2, pv3;
  pk0 = *(const uint4*)(kgp);
  pk1 = *(const uint4*)(kgp + (size_t)16 * 512);
  pk2 = *(const uint4*)(kgp + (size_t)32 * 512);
  pk3 = *(const uint4*)(kgp + (size_t)48 * 512);
  pv0 = *(const uint4*)(vgp);
  pv1 = *(const uint4*)(vgp + (size_t)32 * Lk);
  pv2 = *(const uint4*)(vgp + (size_t)64 * Lk);
  pv3 = *(const uint4*)(vgp + (size_t)96 * Lk);
  for (int kt = 0; kt < nkt; ++kt) {
    {
      bf16_t* dk = sK + a_kr * 136 + a_kc;
      *(uint4*)(dk) = pk0;
      *(uint4*)(dk + 16 * 136) = pk1;
      *(uint4*)(dk + 32 * 136) = pk2;
      *(uint4*)(dk + 48 * 136) = pk3;
      bf16_t* dv = sV + a_vr * 72 + a_vc;
      *(uint4*)(dv) = pv0;
      *(uint4*)(dv + 32 * 72) = pv1;
      *(uint4*)(dv + 64 * 72) = pv2;
      *(uint4*)(dv + 96 * 72) = pv3;
    }
    __syncthreads();
    if (kt + 1 < nkt) {
      const bf16_t* kn = kgp + (size_t)(kt + 1) * 64 * 512;
      const bf16_t* vn = vgp + (kt + 1) * 64;
      pk0 = *(const uint4*)(kn);
      pk1 = *(const uint4*)(kn + (size_t)16 * 512);
      pk2 = *(const uint4*)(kn + (size_t)32 * 512);
      pk3 = *(const uint4*)(kn + (size_t)48 * 512);
      pv0 = *(const uint4*)(vn);
      pv1 = *(const uint4*)(vn + (size_t)32 * Lk);
      pv2 = *(const uint4*)(vn + (size_t)64 * Lk);
      pv3 = *(const uint4*)(vn + (size_t)96 * Lk);
    }
    f32x4 s[2][4];
#pragma unroll
    for (int k16 = 0; k16 < 4; ++k16)
#pragma unroll
      for (int mp = 0; mp < 2; ++mp) {
        f32x4 a = f32x4{0.f, 0.f, 0.f, 0.f};
#pragma unroll
        for (int ch = 0; ch < 2; ++ch) {
          bf16x8 kf = *(const bf16x8*)(sK + (k16 * 16 + fr) * 136 + mp * 64 + ch * 32 + fq * 8);
          a = __builtin_amdgcn_mfma_f32_16x16x32_bf16(kf, qf[mp][ch], a, 0, 0, 0);
        }
        s[mp][k16] = a;
      }
    bf16x8 pf[2][2];
#pragma unroll
    for (int mp = 0; mp < 2; ++mp) {
      float lsum = 0.f;
#pragma unroll
      for (int k16 = 0; k16 < 4; ++k16)
#pragma unroll
        for (int j = 0; j < 4; ++j) {
          float e = __expf(s[mp][k16][j]);
          s[mp][k16][j] = e;
          lsum += e;
        }
      if (mp == 0) ls0 += lsum; else ls1 += lsum;
#pragma unroll
      for (int g = 0; g < 2; ++g) {
        uint4 fu;
        fu.x = pack2(s[mp][2 * g][0], s[mp][2 * g][1]);
        fu.y = pack2(s[mp][2 * g][2], s[mp][2 * g][3]);
        fu.z = pack2(s[mp][2 * g + 1][0], s[mp][2 * g + 1][1]);
        fu.w = pack2(s[mp][2 * g + 1][2], s[mp][2 * g + 1][3]);
        pf[mp][g] = __builtin_bit_cast(bf16x8, fu);
      }
    }
#pragma unroll
    for (int dt = 0; dt < 8; ++dt)
#pragma unroll
      for (int g = 0; g < 2; ++g) {
        const bf16_t* vp = sV + (dt * 16 + fr) * 72 + g * 32 + fq * 4;
        uint2 lo = *(const uint2*)(vp);
        uint2 hi = *(const uint2*)(vp + 16);
        uint4 u = uint4{lo.x, lo.y, hi.x, hi.y};
        bf16x8 vf = __builtin_bit_cast(bf16x8, u);
        O[0][dt] = __builtin_amdgcn_mfma_f32_16x16x32_bf16(vf, pf[0][g], O[0][dt], 0, 0, 0);
        O[1][dt] = __builtin_amdgcn_mfma_f32_16x16x32_bf16(vf, pf[1][g], O[1][dt], 0, 0, 0);
      }
    __syncthreads();
  }
  ls0 += __shfl_xor(ls0, 16); ls0 += __shfl_xor(ls0, 32);
  ls1 += __shfl_xor(ls1, 16); ls1 += __shfl_xor(ls1, 32);
  const float* lamp = (const float*)(p.ws + OFF_LAM);
  const float lam = lamp[l], lam_init = lamp[4 + l];
  const float i0 = 1.f / ls0, i1 = lam / ls1;
  float ss = 0.f;
#pragma unroll
  for (int dt = 0; dt < 8; ++dt)
#pragma unroll
    for (int j = 0; j < 4; ++j) {
      float o = O[0][dt][j] * i0 - O[1][dt][j] * i1;
      O[0][dt][j] = o;
      ss += o * o;
    }
  ss += __shfl_xor(ss, 16); ss += __shfl_xor(ss, 32);
  const float rinv = rsqrtf(ss * (1.0f / 128.0f) + 1e-5f) * (1.f - lam_init);
  const int m = q0 + fr;
  const bf16_t* zg = (const bf16_t*)(p.ws + OFF_Z) + (size_t)m * NIN + C_DAG + h * 128;
  bf16_t* yc = (bf16_t*)(p.ws + OFF_YC) + (size_t)m * 512 + h * 128;
  const float* gsub = p.in[I_GSUB] + l * 128;
#pragma unroll
  for (int dt = 0; dt < 8; ++dt) {
    int dd = dt * 16 + fq * 4;
    uint2 g = *(const uint2*)(zg + dd);
    float4 gs = *(const float4*)(gsub + dd);
    float o0 = O[0][dt][0] * rinv * gs.x * silu(bflo(g.x));
    float o1 = O[0][dt][1] * rinv * gs.y * silu(bfhi(g.x));
    float o2 = O[0][dt][2] * rinv * gs.z * silu(bflo(g.y));
    float o3 = O[0][dt][3] * rinv * gs.w * silu(bfhi(g.y));
    uint2 pk;
    pk.x = pack2(o0, o1);
    pk.y = pack2(o2, o3);
    *(uint2*)(yc + dd) = pk;
  }
}

DEV void hyena_item(const Params& p, int l, int grp, int idx) {
  const int tid = otid(), lane = tid & 63, wid = tid >> 6, fr = lane & 15, fq = lane >> 4;
  const int c = idx * 4 + wid;
  const int L = grp ? 2048 : 256, NB = L >> 4;
  const int gbase = grp ? 4096 : 0;
  const int CLdw = L + 16;
  const unsigned* P0 = (const unsigned*)(p.ws + OFF_G) + (size_t)l * GR_LAYER_DW + (grp ? GR_CTX_DW : 0) +
                       (size_t)(c * 2) * CLdw;
  const unsigned* P1 = P0 + CLdw;
  const bf16_t* UT = (const bf16_t*)(p.ws + OFF_H) + (size_t)c * MTOK + gbase + (fq & 1) * 8;
  f32x4 acc[16];
#pragma unroll
  for (int nb = 0; nb < 16; ++nb) acc[nb] = f32x4{0.f, 0.f, 0.f, 0.f};
  const int I0l = grp ? 0 : 0;
  (void)I0l;
  const bf16_t* zpad = (const bf16_t*)(P0 + L);
  for (int D0 = -NB; D0 < NB; D0 += 2) {
    const int Dp = D0 + (fq >> 1);
    const int q0 = L - 16 * Dp - fr + 8 * (fq & 1);
    const unsigned* ap = (q0 & 1) ? (P1 + ((q0 - 1) >> 1)) : (P0 + (q0 >> 1));
    uint4 au;
    au.x = ap[0]; au.y = ap[1]; au.z = ap[2]; au.w = ap[3];
    uint4 bu[16];
#pragma unroll
    for (int nb = 0; nb < 16; ++nb) {
      const int I0 = grp ? (nb & 7) * 16 : 0;
      const int J = I0 + fr - Dp;
      const bool valid = (unsigned)J < (unsigned)NB;
      const bf16_t* bp = valid ? (UT + nb * 256 + (fr - Dp) * 16) : zpad;
      bu[nb] = *(const uint4*)bp;
    }
    const bf16x8 af = __builtin_bit_cast(bf16x8, au);
#pragma unroll
    for (int nb = 0; nb < 16; ++nb)
      acc[nb] = __builtin_amdgcn_mfma_f32_16x16x32_bf16(af, __builtin_bit_cast(bf16x8, bu[nb]), acc[nb], 0, 0, 0);
  }
  float* YT = (float*)(p.ws + OFF_UU) + (size_t)c * MTOK + gbase + 16 * fr + 4 * fq;
#pragma unroll
  for (int nb = 0; nb < 16; ++nb) *(f32x4*)(YT + nb * 256) = acc[nb];
}

DEV void hyena_epi(const Params& p, int idx, float* tile) {
  const int tid = otid();
  const int m0 = (idx & 127) * 64, c0 = (idx >> 7) * 64;
  const float* YT = (const float*)(p.ws + OFF_UU);
  {
    int c = tid >> 2, mq = (tid & 3) * 16;
    const float* src = YT + (size_t)(c0 + c) * MTOK + m0 + mq;
#pragma unroll
    for (int e = 0; e < 4; ++e) {
      float4 v = *(const float4*)(src + e * 4);
      float* d = tile + c * 65 + mq + e * 4;
      d[0] = v.x; d[1] = v.y; d[2] = v.z; d[3] = v.w;
    }
  }
  __syncthreads();
  {
    int m = tid >> 2, cq = (tid & 3) * 16;
    size_t mm = (size_t)(m0 + m);
    const float* x1 = (const float*)(p.ws + OFF_X1) + mm * 512 + c0 + cq;
    const bf16_t* zg = (const bf16_t*)(p.ws + OFF_Z) + mm * NIN + C_HYG + c0 + cq;
    bf16_t* ya = (bf16_t*)(p.ws + OFF_YA) + mm * 512 + c0 + cq;
    unsigned ow[8];
#pragma unroll
    for (int e = 0; e < 8; ++e) {
      v2f xv = *(const v2f*)(x1 + e * 2);
      unsigned g = *(const unsigned*)(zg + e * 2);
      float y0 = tile[(cq + e * 2) * 65 + m], y1 = tile[(cq + e * 2 + 1) * 65 + m];
      ow[e] = pack2(xv.x * y0 * silu(bflo(g)), xv.y * y1 * silu(bfhi(g)));
    }
    *(uint4*)(ya) = uint4{ow[0], ow[1], ow[2], ow[3]};
    *(uint4*)(ya + 8) = uint4{ow[4], ow[5], ow[6], ow[7]};
  }
  __syncthreads();
}

DEV void rwkv_fin(const Params& p, int l, int idx) {
  const int tid = otid();
  const int kq = tid & 15;
  const size_t DSTR = (size_t)MTOK * 512;
  const float* Y = (const float*)(p.ws + OFF_Y);
  const float* KD = (const float*)(p.ws + OFF_KD);
  float4 y0[2], y1[2], k0[2], k1[2], r[2], v[2], lw[2], lb[2], rk[2];
  uint2 g[2];
  size_t o[2];
#pragma unroll
  for (int u = 0; u < 2; ++u) {
    const int pr = idx * 32 + u * 16 + (tid >> 4);
    const int m = pr >> 3, h = pr & 7;
    const int c = h * 64 + kq * 4;
    o[u] = (size_t)m * 512 + c;
    y0[u] = *(const float4*)(Y + o[u]); y1[u] = *(const float4*)(Y + DSTR + o[u]);
    k0[u] = *(const float4*)(KD + o[u]); k1[u] = *(const float4*)(KD + DSTR + o[u]);
    r[u] = *(const float4*)((const float*)(p.ws + OFF_R) + o[u]);
    v[u] = *(const float4*)((const float*)(p.ws + OFF_V) + o[u]);
    g[u] = *(const uint2*)((const bf16_t*)(p.ws + OFF_Z) + (size_t)m * NIN + C_RWG + c);
    lw[u] = *(const float4*)(p.in[I_RLNW] + l * 512 + c);
    lb[u] = *(const float4*)(p.in[I_RLNB] + l * 512 + c);
    rk[u] = *(const float4*)(p.in[I_RRK] + l * 512 + c);
  }
#pragma unroll
  for (int u = 0; u < 2; ++u) {
    float4 y = float4{y0[u].x + y1[u].x, y0[u].y + y1[u].y, y0[u].z + y1[u].z, y0[u].w + y1[u].w};
    float mean = dpp_sum16(y.x + y.y + y.z + y.w) * (1.0f / 64.0f);
    float4 dv = float4{y.x - mean, y.y - mean, y.z - mean, y.w - mean};
    float var = dpp_sum16(dv.x * dv.x + dv.y * dv.y + dv.z * dv.z + dv.w * dv.w) * (1.0f / 64.0f);
    float rs = rsqrtf(var + 64e-5f);
    float bs = dpp_sum16(r[u].x * 0.5f * (k0[u].x + k1[u].x) * rk[u].x + r[u].y * 0.5f * (k0[u].y + k1[u].y) * rk[u].y +
                         r[u].z * 0.5f * (k0[u].z + k1[u].z) * rk[u].z + r[u].w * 0.5f * (k0[u].w + k1[u].w) * rk[u].w);
    float o0 = (dv.x * rs * lw[u].x + lb[u].x + bs * v[u].x) * silu(bflo(g[u].x));
    float o1 = (dv.y * rs * lw[u].y + lb[u].y + bs * v[u].y) * silu(bfhi(g[u].x));
    float o2 = (dv.z * rs * lw[u].z + lb[u].z + bs * v[u].z) * silu(bflo(g[u].y));
    float o3 = (dv.w * rs * lw[u].w + lb[u].w + bs * v[u].w) * silu(bfhi(g[u].y));
    uint2 pk;
    pk.x = pack2(o0, o1);
    pk.y = pack2(o2, o3);
    *(uint2*)((bf16_t*)(p.ws + OFF_YB) + o[u]) = pk;
  }
}

#define XB_TMO      128
#define XB_XCNT(j)  (256  + 64 * (j))
#define XB_XSUB(j)  (1280 + 64 * (j))
#define XB_XGEN(j)  (2304 + 64 * (j))
#define XB_TOP      3328
#define XB_TOPGEN   3392
#define XCD_BAR_WORDS 3456
#define XB_SPIN_CAP (1u << 18)
#define LAS __attribute__((address_space(3)))
DEV unsigned xb_ld(unsigned* p) { return __hip_atomic_load(p, __ATOMIC_RELAXED, __HIP_MEMORY_SCOPE_AGENT); }
DEV unsigned xb_add(unsigned* p, unsigned v) { return __hip_atomic_fetch_add(p, v, __ATOMIC_RELAXED, __HIP_MEMORY_SCOPE_AGENT); }
DEV unsigned xb_xcc_id() { return (unsigned)__builtin_amdgcn_s_getreg((3 << 11) | 20) & 0xFu; }
#define XB_SPIN(cond, bar) do { unsigned _sp = 0; while (cond) { __builtin_amdgcn_s_sleep(1); \
    if ((++_sp & 255u) == 0u) { if (xb_ld(&(bar)[XB_TMO])) break; if (_sp > XB_SPIN_CAP) { atomicAdd(&(bar)[XB_TMO], 1u); break; } } } } while (0)
struct XcdBarrier { unsigned* bar; unsigned x; volatile LAS unsigned* st; };
DEV XcdBarrier xcd_barrier_post(unsigned* bar, volatile LAS unsigned* st) {
  XcdBarrier b; b.bar = bar; b.x = xb_xcc_id(); b.st = st;
  if (threadIdx.x == 0) (void)xb_add(&bar[XB_XCNT(b.x)], 1u);
  return b;
}
DEV void xcd_barrier_complete(unsigned* bar, unsigned x, unsigned& nloc, unsigned& nx) {
  const unsigned G = gridDim.x * gridDim.y * gridDim.z;
  unsigned sum, cnt, mine, sp = 0u;
  for (;;) {
    sum = 0u; cnt = 0u; mine = 0u;
#pragma unroll
    for (unsigned j = 0; j < 16; ++j) { const unsigned c = xb_ld(&bar[XB_XCNT(j)]); sum += c; cnt += (c > 0u) ? 1u : 0u; mine = (j == x) ? c : mine; }
    if (sum == G) break;
    __builtin_amdgcn_s_sleep(1);
    if ((++sp & 255u) == 0u) { if (xb_ld(&bar[XB_TMO])) break; if (sp > XB_SPIN_CAP) { atomicAdd(&bar[XB_TMO], 1u); break; } }
  }
  nloc = mine > 0u ? mine : 1u; nx = cnt > 0u ? cnt : 1u;
}
DEV void xcd_barrier(const XcdBarrier& b) {
  asm volatile("s_waitcnt vmcnt(0)" ::: "memory");
  __syncthreads();
  if (threadIdx.x == 0) {
    unsigned* bar = b.bar;
    __builtin_amdgcn_s_waitcnt(0);
    unsigned nloc = b.st[0], nx = b.st[1];
    if (nloc == 0u) { xcd_barrier_complete(bar, b.x, nloc, nx); b.st[0] = nloc; b.st[1] = nx; }
    const unsigned old = xb_add(&bar[XB_XSUB(b.x)], 1u);
    const unsigned gen = old / nloc;
    if (old + 1u == (gen + 1u) * nloc) {
      __builtin_amdgcn_fence(__ATOMIC_RELEASE, "agent");
      asm volatile("s_waitcnt vmcnt(0)" ::: "memory");
      const unsigned og = xb_add(&bar[XB_TOP], 1u);
      const unsigned tg = og / nx;
      if (og + 1u == (tg + 1u) * nx) xb_add(&bar[XB_TOPGEN], 1u);
      else XB_SPIN(xb_ld(&bar[XB_TOPGEN]) == tg, bar);
      __builtin_amdgcn_fence(__ATOMIC_ACQUIRE, "agent");
      xb_add(&bar[XB_XGEN(b.x)], 1u);
      asm volatile("s_waitcnt vmcnt(0)" ::: "memory");
    } else {
      XB_SPIN(xb_ld(&bar[XB_XGEN(b.x)]) == gen, bar);
      __builtin_amdgcn_fence(__ATOMIC_ACQUIRE, "agent");
      asm volatile("s_waitcnt vmcnt(0)" ::: "memory");
    }
  }
  __syncthreads();
}

DEV void run_phase(const Params& p, int ph, char* smem, int* s_item_p) {
  const int nb = gridDim.x, bid = blockIdx.x;
  unsigned* counters = (unsigned*)(p.ws + OFF_CNT);
  if (ph == 0) {
    if (bid == 0 && threadIdx.x < 8) counters[threadIdx.x] = 0u;
    for (int it = bid; it < 4353; it += nb) {
      asm volatile("" ::: "memory");
      if (it < 192) p0_mod(p, it, (float*)smem);
      else if (it == 192) p0_misc(p);
      else if (it < 193 + 1152) p0_filter(p, it - 193, (float*)smem);
      else p0_transpose(p, it - 1345, (float*)smem);
    }
    return;
  }
  const int l = (ph - 1) / 7, st = (ph - 1) % 7;
  if (st == 0) {
    for (int it = bid; it < 1024; it += nb) { asm volatile("" ::: "memory"); norm_item(p, l, it); }
  } else if (st == 1) {
    for (int it = bid; it < 4736; it += nb) { asm volatile("" ::: "memory"); gemm_in_tile(p, l, it, (bf16_t*)smem); }
  } else if (st == 2) {
    for (int it = bid; it < 2608; it += nb) {
      asm volatile("" ::: "memory");
      if (it < 1024) prep_rwkv(p, l, it, (float*)smem);
      else if (it < 1536) prep_hyena(p, l, it - 1024);
      else if (it < 2048) prep_qk(p, l, it - 1536);
      else if (it < 2064) prep_kcache(p, l, it - 2048);
      else prep_vt(p, l, it - 2064, (bf16_t*)smem);
    }
  } else if (st == 3) {
    while (true) {
      __syncthreads();
      if (threadIdx.x == 0) *s_item_p = (int)atomicAdd(&counters[l], 1u);
      __syncthreads();
      int it = *s_item_p;
      asm volatile("" ::: "memory");
      if (it >= 1920) break;
      if (it < 128) {
        int b = it >> 6, r = it & 63;
        scan_item(p, l, 4096 + b * 2048, 2048, b, false, r >> 3, (r >> 2) & 1, r & 3, (float*)smem);
      } else if (it < 1152) {
        int i2 = it - 128;
        int b = i2 >> 6, r = i2 & 63;
        scan_item(p, l, b * 256, 256, b, true, r >> 3, (r >> 2) & 1, r & 3, (float*)smem);
      } else if (it < 1408) {
        int i2 = it - 1152;
        int b = i2 >> 7, h = (i2 >> 5) & 3, qt = i2 & 31;
        const bf16_t* vt = (const bf16_t*)(p.ws + OFF_VT) + (size_t)4096 * 512 + (size_t)(b * 4 + h) * 128 * 2304;
        attn_item(p, l, 4096 + b * 2048, qt, h, (size_t)4096 + (size_t)b * 2304, 2304, vt, (bf16_t*)smem);
      } else if (it < 1536) {
        hyena_item(p, l, 1, it - 1408);
      } else if (it < 1792) {
        int i2 = it - 1536;
        int b = i2 >> 4, h = (i2 >> 2) & 3, qt = i2 & 3;
        const bf16_t* vt = (const bf16_t*)(p.ws + OFF_VT) + (size_t)(b * 4 + h) * 128 * 256;
        attn_item(p, l, b * 256, qt, h, (size_t)b * 256, 256, vt, (bf16_t*)smem);
      } else {
        hyena_item(p, l, 0, it - 1792);
      }
    }
  } else if (st == 4) {
    for (int it = bid; it < 3072; it += nb) {
      asm volatile("" ::: "memory");
      if (it < 2048) rwkv_fin(p, l, it); else hyena_epi(p, it - 2048, (float*)smem);
    }
  } else if (st == 5) {
    for (int it = bid; it < 512; it += nb) { asm volatile("" ::: "memory"); gemm_br_tile(p, l, it, (bf16_t*)smem); }
  } else {
    for (int it = bid; it < 512; it += nb) { asm volatile("" ::: "memory"); gemm_out_tile(p, l, it, (bf16_t*)smem); }
  }
}

#ifndef MULTI_LAUNCH
#define MULTI_LAUNCH 0
#endif

__global__ void __launch_bounds__(NT, 2) fwd_megakernel(Params p, int ph0, int ph1) {
  __shared__ __attribute__((aligned(16))) char smem[SMEM_BYTES];
  __shared__ int s_item;
  __shared__ uint4 xb_words;
#if !MULTI_LAUNCH
  cg::grid_group grid = cg::this_grid();
  if (ph0 < 0) grid.sync();
  if (threadIdx.x == 0) xb_words = make_uint4(0u, 0u, 0u, 0u);
  __syncthreads();
  XcdBarrier xb = xcd_barrier_post((unsigned*)(p.ws + OFF_BAR), (volatile LAS unsigned*)&xb_words);
#endif
  for (int ph = ph0; ph < ph1; ++ph) {
#if !MULTI_LAUNCH
    if (ph > ph0) xcd_barrier(xb);
#endif
    run_phase(p, ph, smem, &s_item);
  }
}

extern "C" void kernel_launch(void* const* d_in, const int* in_sizes, int n_in, void* d_out, int out_size, void* d_ws,
                              size_t ws_size, hipStream_t stream) {
  if (n_in < 39 || ws_size < WS_NEED) {
    fprintf(stderr, "kernel_launch: bad inputs n_in=%d ws=%zu need=%zu\n", n_in, ws_size, (size_t)WS_NEED);
    return;
  }
  static int grid_blocks = 0;
  if (!grid_blocks) {
    int dev = 0, cus = 0, per_cu = 0;
    (void)hipGetDevice(&dev);
    (void)hipDeviceGetAttribute(&cus, hipDeviceAttributeMultiprocessorCount, dev);
    (void)hipOccupancyMaxActiveBlocksPerMultiprocessor(&per_cu, fwd_megakernel, NT, 0);
    if (per_cu < 1) per_cu = 1;
    if (per_cu > 2) per_cu = 2;
    grid_blocks = cus * per_cu;
  }
  Params p{};
  for (int i = 0; i < 39; ++i) p.in[i] = (const float*)d_in[i];
  p.out = (float*)d_out;
  p.ws = (char*)d_ws;
#if !MULTI_LAUNCH
  (void)hipMemsetAsync((char*)d_ws + OFF_BAR, 0, XCD_BAR_WORDS_C * 4, stream);
#endif
#if MULTI_LAUNCH
  for (int ph = 0; ph < 29; ++ph) fwd_megakernel<<<dim3(grid_blocks), dim3(NT), 0, stream>>>(p, ph, ph + 1);
#else
  int ph0 = 0, ph1 = 29;
  void* args[] = {&p, &ph0, &ph1};
  hipError_t e = hipLaunchCooperativeKernel((void*)fwd_megakernel, dim3(grid_blocks), dim3(NT), args, 0, stream);
  if (e != hipSuccess) fprintf(stderr, "cooperative launch failed: %s (grid %d)\n", hipGetErrorString(e), grid_blocks);
#endif
}
```
